# Optimizing an MI355X kernel written in HIP

```python
import math
import jax, jax.numpy as jnp
from jax import lax
import numpy as np

D_MODEL = 4096
BATCH = 1
SEQ = 16384
DEPTH = 4

CHUNK = 64
QBLOCK = 128
N_A_LAYERS = DEPTH // 2
N_B_LAYERS = DEPTH - N_A_LAYERS
DH_A = 128
H_A = D_MODEL // DH_A
DH_B = 128
H_B = D_MODEL // (2 * DH_B)
DV_B = 2 * DH_B
D_FF = 3 * D_MODEL // 2
EPS = 1e-6
FGATE_BIAS = 3.0

kernel_name = "fox_diffattn_yoco_macaron"


def rms_norm(x, g):
    xf = x.astype(jnp.float32)
    y = xf * lax.rsqrt(jnp.mean(xf * xf, axis=-1, keepdims=True) + EPS)
    return (y * g.astype(jnp.float32)).astype(x.dtype)


def swiglu(x, w_in, w_out):
    g, u = jnp.split(x @ w_in, 2, axis=-1)
    return (jax.nn.silu(g) * u) @ w_out


def _to_blocks(a):
    b, s = a.shape[:2]
    a = a.reshape((b, s // QBLOCK, QBLOCK) + a.shape[2:])
    return jnp.moveaxis(a, 1, 0)


def _from_blocks(a):
    a = jnp.moveaxis(a, 0, 1)
    return a.reshape((a.shape[0], a.shape[1] * a.shape[2]) + a.shape[3:])


def forgetting_attention(q, k, v, log_f):
    s_len, dh = q.shape[1], q.shape[-1]
    scale = dh ** -0.5
    dcum = jnp.cumsum(log_f, axis=1)
    dcum_k = jnp.swapaxes(dcum, 1, 2)
    pos = jnp.arange(s_len)
    qpos = pos.reshape(-1, QBLOCK)

    def block(args):
        q_blk, d_blk, p_blk = args
        logits = jnp.einsum('bqhd,bkhd->bhqk', q_blk, k,
                            preferred_element_type=jnp.float32) * scale
        logits = logits + jnp.swapaxes(d_blk, 1, 2)[..., None] - dcum_k[:, :, None, :]
        causal = pos[None, :] <= p_blk[:, None]
        logits = jnp.where(causal, logits, -jnp.inf)
        p = jax.nn.softmax(logits, axis=-1)
        return jnp.einsum('bhqk,bkhd->bqhd', p.astype(v.dtype), v)

    out = lax.map(block, (_to_blocks(q), _to_blocks(dcum), qpos))
    return _from_blocks(out)


def differential_attention(q, k, v, lam):
    s_len, n_heads, dh = q.shape[1], q.shape[2], q.shape[-1]
    scale = dh ** -0.5
    slopes = jnp.exp2(-8.0 * jnp.arange(1, n_heads + 1, dtype=jnp.float32) / n_heads)
    pos = jnp.arange(s_len)
    qpos = pos.reshape(-1, QBLOCK)

    def block(args):
        q_blk, p_blk = args
        dist = jnp.abs(p_blk[:, None] - pos[None, :]).astype(jnp.float32)
        visible = (pos[None, :] // CHUNK) <= (p_blk[:, None] // CHUNK)
        bias = jnp.where(visible, -slopes[:, None, None] * dist, -jnp.inf)
        logits = jnp.einsum('bqhmd,bkhmd->bmhqk', q_blk, k,
                            preferred_element_type=jnp.float32) * scale + bias
        attn = jax.nn.softmax(logits, axis=-1)
        w = attn[:, 0] - lam * attn[:, 1]
        return jnp.einsum('bhqk,bkhe->bqhe', w.astype(v.dtype), v)

    return _from_blocks(lax.map(block, (_to_blocks(q), qpos)))


def fox_mixer(hn, w_in, b_f, w_out):
    b, s, _ = hn.shape
    width = H_A * DH_A
    q, k, v, f = jnp.split(hn @ w_in, [width, 2 * width, 3 * width], axis=-1)
    shp = (b, s, H_A, DH_A)
    log_f = jax.nn.log_sigmoid((f + b_f).astype(jnp.float32))
    o = forgetting_attention(q.reshape(shp), k.reshape(shp), v.reshape(shp), log_f)
    return o.reshape(b, s, width) @ w_out


def diff_mixer(hn, k_sh, v_sh, w_q, lam_vecs, g_subln, w_out, layer_idx):
    b, s, _ = hn.shape
    lam_init = 0.8 - 0.6 * math.exp(-0.3 * (layer_idx - 1))
    lv = lam_vecs.astype(jnp.float32)
    lam = jnp.exp(jnp.sum(lv[0] * lv[1])) - jnp.exp(jnp.sum(lv[2] * lv[3])) + lam_init
    q = (hn @ w_q).reshape(b, s, H_B, 2, DH_B)
    o = differential_attention(q, k_sh, v_sh, lam)
    o = rms_norm(o, g_subln) * (1.0 - lam_init)
    return o.reshape(b, s, H_B * DV_B) @ w_out


def setup_inputs(seed: int = 0) -> dict:
    key = jax.random.key(seed)
    ks = jax.random.split(key, 16)
    f32 = jnp.float32

    def nrm(k, shape, fan_in):
        return jax.random.normal(k, shape, f32) * (fan_in ** -0.5)

    def gain(k, shape):
        return 1.0 + 0.02 * jax.random.normal(k, shape, f32)

    qkv_a = 3 * H_A * DH_A + H_A
    return {
        "x": jax.random.normal(ks[0], (BATCH, SEQ, D_MODEL), f32),
        "g_ffn": gain(ks[1], (DEPTH, 2, D_MODEL)),
        "w_ffn_in": nrm(ks[2], (DEPTH, 2, D_MODEL, 2 * D_FF), D_MODEL),
        "w_ffn_out": nrm(ks[3], (DEPTH, 2, D_FF, D_MODEL), D_FF),
        "g_mix": gain(ks[4], (DEPTH, D_MODEL)),
        "w_in_a": nrm(ks[5], (N_A_LAYERS, D_MODEL, qkv_a), D_MODEL),
        "b_f": FGATE_BIAS + 0.1 * jax.random.normal(ks[6], (N_A_LAYERS, H_A), f32),
        "w_out_a": nrm(ks[7], (N_A_LAYERS, H_A * DH_A, D_MODEL), H_A * DH_A),
        "g_kv": gain(ks[8], (D_MODEL,)),
        "w_kv": nrm(ks[9], (D_MODEL, H_B * 2 * DH_B + H_B * DV_B), D_MODEL),
        "w_q_b": nrm(ks[10], (N_B_LAYERS, D_MODEL, H_B * 2 * DH_B), D_MODEL),
        "lam_b": 0.1 * jax.random.normal(ks[11], (N_B_LAYERS, 4, DH_B), f32),
        "g_subln": gain(ks[12], (N_B_LAYERS, DV_B)),
        "w_out_b": nrm(ks[13], (N_B_LAYERS, H_B * DV_B, D_MODEL), H_B * DV_B),
        "g_final": gain(ks[14], (D_MODEL,)),
    }


def reference(x, g_ffn, w_ffn_in, w_ffn_out, g_mix, w_in_a, b_f, w_out_a,
              g_kv, w_kv, w_q_b, lam_b, g_subln, w_out_b, g_final):
    b, s, _ = x.shape
    h = x
    k_sh = None
    v_sh = None
    for l in range(DEPTH):
        h = h + 0.5 * swiglu(rms_norm(h, g_ffn[l, 0]), w_ffn_in[l, 0], w_ffn_out[l, 0])
        hn = rms_norm(h, g_mix[l])
        if l < N_A_LAYERS:
            h = h + fox_mixer(hn, w_in_a[l], b_f[l], w_out_a[l])
        else:
            j = l - N_A_LAYERS
            h = h + diff_mixer(hn, k_sh, v_sh, w_q_b[j], lam_b[j], g_subln[j],
                               w_out_b[j], l + 1)
        h = h + 0.5 * swiglu(rms_norm(h, g_ffn[l, 1]), w_ffn_in[l, 1], w_ffn_out[l, 1])
        if l == N_A_LAYERS - 1:
            kv = rms_norm(h, g_kv) @ w_kv
            k_flat, v_flat = jnp.split(kv, [H_B * 2 * DH_B], axis=-1)
            k_sh = k_flat.reshape(b, s, H_B, 2, DH_B)
            v_sh = v_flat.reshape(b, s, H_B, DV_B)
    return rms_norm(h, g_final)
```

```cpp
#include <hip/hip_runtime.h>
#include <cstdio>
#include <cstdint>

__device__ __forceinline__ int tid_of(int wv) { asm volatile("" : "+s"(wv)); unsigned z = 0u; asm volatile("" : "+v"(z));
    return (wv << 6) | (int)__builtin_amdgcn_mbcnt_hi(~0u, __builtin_amdgcn_mbcnt_lo(~0u, z)); }

#ifndef MK_MULTI_LAUNCH
#define MK_MULTI_LAUNCH 0
#endif

namespace pg8 {
#define PG8_LAS __attribute__((address_space(3)))
typedef unsigned short bf16_t;
typedef short bf16x8 __attribute__((ext_vector_type(8)));
typedef float f32x4 __attribute__((ext_vector_type(4)));
typedef unsigned u32x4 __attribute__((ext_vector_type(4)));
constexpr int BM = 256, BK = 64, HALF = 128, HTB = HALF * BK * 2  , STAGE_BYTES = 8 * HTB, NXCD = 8, WGM = 8;

__host__ __device__ __forceinline__ int lds_byte(int r, int c) { const int st = (r >> 4) * 2 + (c >> 5), rr = r & 15, cc = c & 31, ob = rr * 64 + cc * 2; return st * 1024 + (ob ^ (((ob >> 9) & 1) << 5)); }
__host__ __device__ __forceinline__ void stage_rc(int b, int& R, int& C) { const int st = b / 1024, sb = b % 1024, swz = sb ^ (((sb >> 9) & 1) << 5); R = (st >> 1) * 16 + swz / 64; C = (st & 1) * 32 + (swz % 64) / 2; }
__host__ __device__ __forceinline__ int perm32(int rho) { const int n = rho >> 4, i = rho & 15; return 8 * (i >> 2) + 4 * n + (i & 3); }

struct Unit { int pm, pn; };
struct Gemm { const bf16_t* A; const bf16_t* Bt; int M, N, K; };

struct StaticOrder {
    int nM, nN, nwg, G, c;
    __host__ __device__ void init(int M, int N, int G_, int c_) { nM = M / BM; nN = N / BM; nwg = nM * nN; G = G_; c = c_; }
    __host__ __device__ bool next(int i, Unit& u) const {
        const long L = (long)i * G + c; if (L >= nwg) return false;
        int wgid = (int)L; { const int q = nwg / NXCD, r = nwg % NXCD, xcd = wgid % NXCD, off = wgid / NXCD; wgid = (xcd < r ? xcd * (q + 1) : r * (q + 1) + (xcd - r) * q) + off; }
        const int nig = WGM * nN, gid = wgid / nig, fm = gid * WGM, gsz = (nM - fm) < WGM ? (nM - fm) : WGM;
        u.pm = fm + ((wgid % nig) % gsz); u.pn = (wgid % nig) / gsz; return true;
    }
    __device__ __forceinline__ void a_ready(const Unit&) const {}
    __device__ __forceinline__ void done(const Unit&) const {}
};


__device__ __forceinline__ unsigned cvt_pk_bf16(float lo, float hi) { unsigned r; asm volatile("v_cvt_pk_bf16_f32 %0, %1, %2" : "=v"(r) : "v"(lo), "v"(hi)); return r; }

struct EpiBf16 {   static constexpr bool ALIGN = true;
    static constexpr bool PERM = true, AFTER_DRAIN = false;
    bf16_t* O; int ldc; int split_cols; size_t split_stride;
    __device__ __forceinline__ void operator()(const f32x4 (&acc)[2][2][4][2], const Unit& u, int wr, int wc, int fr, int fq) const {
        const int row0 = u.pm * BM + wr * 64 + fr; int colt = u.pn * BM; bf16_t* base = O;
        if (split_cols) { const int t = colt / split_cols; base += (size_t)t * split_stride; colt -= t * split_cols; }
        const int col0 = colt + wc * 32 + 8 * fq;
#pragma unroll
        for (int ai = 0; ai < 2; ++ai)
#pragma unroll
            for (int m = 0; m < 4; ++m) { bf16_t* rowp = base + (size_t)(row0 + ai * HALF + m * 16) * ldc + col0;
#pragma unroll
                for (int bj = 0; bj < 2; ++bj) { const f32x4 v0 = acc[ai][bj][m][0], v1 = acc[ai][bj][m][1];
                    u32x4 w; w.x = cvt_pk_bf16(v0[0], v0[1]); w.y = cvt_pk_bf16(v0[2], v0[3]); w.z = cvt_pk_bf16(v1[0], v1[1]); w.w = cvt_pk_bf16(v1[2], v1[3]);
                    *(u32x4*)(rowp + bj * HALF) = w; } }
    }
};
__device__ __forceinline__ float silu_mul(float g, float u) { return g * u * __builtin_amdgcn_rcpf(1.0f + __builtin_amdgcn_exp2f(-1.4426950408889634f * g)); }
struct EpiSwiGLU {
    static constexpr bool ALIGN = true;
    static constexpr bool PERM = true, AFTER_DRAIN = false;
    bf16_t* O; int ldc;
    __device__ __forceinline__ void operator()(const f32x4 (&acc)[2][2][4][2], const Unit& u, int wr, int wc, int fr, int fq) const {
        const int row0 = u.pm * BM + wr * 64 + fr, col0 = u.pn * HALF + wc * 32 + 8 * fq;
#pragma unroll
        for (int ai = 0; ai < 2; ++ai)
#pragma unroll
            for (int m = 0; m < 4; ++m) { bf16_t* rowp = O + (size_t)(row0 + ai * HALF + m * 16) * ldc + col0;
                const f32x4 g0 = acc[ai][0][m][0], g1 = acc[ai][0][m][1], u0 = acc[ai][1][m][0], u1 = acc[ai][1][m][1];
                u32x4 w; w.x = cvt_pk_bf16(silu_mul(g0[0], u0[0]), silu_mul(g0[1], u0[1])); w.y = cvt_pk_bf16(silu_mul(g0[2], u0[2]), silu_mul(g0[3], u0[3]));
                w.z = cvt_pk_bf16(silu_mul(g1[0], u1[0]), silu_mul(g1[1], u1[1])); w.w = cvt_pk_bf16(silu_mul(g1[2], u1[2]), silu_mul(g1[3], u1[3]));
                *(u32x4*)rowp = w; }
    }
};
typedef _Float16 h16x8 __attribute__((ext_vector_type(8)));
__device__ __forceinline__ h16x8 to_h16x8(f32x4 a, f32x4 b) { h16x8 r;
#pragma unroll
    for (int j = 0; j < 4; ++j) { r[j] = (_Float16)fminf(fmaxf(a[j], -65504.f), 65504.f); r[4 + j] = (_Float16)fminf(fmaxf(b[j], -65504.f), 65504.f); }
    return r; }
struct EpiResidF16 {
    static constexpr bool ALIGN = true;
    static constexpr bool PERM = true, AFTER_DRAIN = false;
    const float* basef; _Float16* h; int ldc; float alpha;
    __device__ __forceinline__ void operator()(const f32x4 (&acc)[2][2][4][2], const Unit& u, int wr, int wc, int fr, int fq) const {
        const int row0 = u.pm * BM + wr * 64 + fr, col0 = u.pn * BM + wc * 32 + 8 * fq;
        if (basef) {
#pragma unroll
            for (int g = 0; g < 8; ++g) { const int ai = g >> 2, m = g & 3; const size_t off = (size_t)(row0 + ai * HALF + m * 16) * ldc + col0;
#pragma unroll
                for (int bj = 0; bj < 2; ++bj) { const f32x4 b0 = *(const f32x4*)(basef + off + bj * HALF), b1 = *(const f32x4*)(basef + off + bj * HALF + 4);
                    *(h16x8*)(h + off + bj * HALF) = to_h16x8(b0 + acc[ai][bj][m][0] * alpha, b1 + acc[ai][bj][m][1] * alpha); }
                asm volatile("" ::: "memory"); }
        } else {
            h16x8 nb[2];
            { const size_t off = (size_t)row0 * ldc + col0; nb[0] = *(const h16x8*)(h + off); nb[1] = *(const h16x8*)(h + off + HALF); }
#pragma unroll
            for (int g = 0; g < 8; ++g) { const int ai = g >> 2, m = g & 3; const size_t off = (size_t)(row0 + ai * HALF + m * 16) * ldc + col0;
                const h16x8 c0 = nb[0], c1 = nb[1];
                if (g + 1 < 8) { const size_t offn = (size_t)(row0 + ((g + 1) >> 2) * HALF + ((g + 1) & 3) * 16) * ldc + col0; nb[0] = *(const h16x8*)(h + offn); nb[1] = *(const h16x8*)(h + offn + HALF); }
                asm volatile("" ::: "memory");
#pragma unroll
                for (int bj = 0; bj < 2; ++bj) { const h16x8 c = bj ? c1 : c0;
                    const f32x4 b0 = {(float)c[0], (float)c[1], (float)c[2], (float)c[3]}, b1 = {(float)c[4], (float)c[5], (float)c[6], (float)c[7]};
                    *(h16x8*)(h + off + bj * HALF) = to_h16x8(b0 + acc[ai][bj][m][0] * alpha, b1 + acc[ai][bj][m][1] * alpha); }
                asm volatile("" ::: "memory"); }
        }
    }
};

template <class Epi, class Sched, bool ALIGN_EPI = false, bool SP2 = false>
__device__ __forceinline__ void gemm_phase(PG8_LAS unsigned char* lds, const Gemm g, const Sched& S, const Epi& E, int wv) {
    const int tid_ = tid_of(wv);
    const int tid = tid_, wid = __builtin_amdgcn_readfirstlane(tid >> 6), lane = tid & 63, wr = wid >> 2, wc = wid & 3, fr = lane & 15, fq = lane >> 4;
    const int K = g.K, nt = K / BK;
    unsigned voffA[2], voffB[2];
#pragma unroll
    for (int i = 0; i < 2; ++i) { int R, C; stage_rc(tid * 16 + i * 8192, R, C); const int Rb = Epi::PERM ? ((R & ~31) + perm32(R & 31)) : R;
        voffA[i] = (unsigned)(R * K + C) * 2u; voffB[i] = (unsigned)(Rb * K + C) * 2u; }
    const size_t kstep = (size_t)(BK * 2);
    const size_t hstep = (size_t)HALF * K * 2;
    const size_t tstep = 2 * hstep;
    const unsigned ldsw = (unsigned)wid * 1024u;
    const int aoff = lds_byte(wr * 64 + fr, fq * 8), boff = lds_byte(wc * 32 + fr, fq * 8);
#define PG8_SA(b, h) (((b) * 2 + (h)) * HTB)
#define PG8_SB(b, h) ((4 + (b) * 2 + (h)) * HTB)
#define PG8_STAGE(bufoff, gbase, voff) do { _Pragma("unroll") for (int _i = 0; _i < 2; ++_i) \
        __builtin_amdgcn_global_load_lds((const unsigned*)((const char*)(gbase) + (voff)[_i]), (PG8_LAS unsigned*)(lds + (bufoff) + ldsw + _i * 8192), 16, 0, 0); } while (0)
#define PG8_LDA(dst, b, h) do { _Pragma("unroll") for (int m = 0; m < 4; ++m) _Pragma("unroll") for (int k = 0; k < 2; ++k) dst[m][k] = *(const PG8_LAS bf16x8*)(lds + PG8_SA(b, h) + aoff + m * 2048 + k * 1024); } while (0)
#define PG8_LDB(dst, b, h) do { _Pragma("unroll") for (int n = 0; n < 2; ++n) _Pragma("unroll") for (int k = 0; k < 2; ++k) dst[n][k] = *(const PG8_LAS bf16x8*)(lds + PG8_SB(b, h) + boff + n * 2048 + k * 1024); } while (0)
#define PG8_MMA(ai, bj, At, Bt) do { __builtin_amdgcn_s_setprio(1); _Pragma("unroll") for (int m = 0; m < 4; ++m) _Pragma("unroll") for (int n = 0; n < 2; ++n) _Pragma("unroll") for (int k = 0; k < 2; ++k) \
        acc[ai][bj][m][n] = __builtin_amdgcn_mfma_f32_16x16x32_bf16(Bt[n][k], At[m][k], acc[ai][bj][m][n], 0, 0, 0); __builtin_amdgcn_s_setprio(0); } while (0)
#define PG8_WAIT_V(n) asm volatile("s_waitcnt vmcnt(" #n ")" ::: "memory")
#define PG8_WAIT_L(n) asm volatile("s_waitcnt lgkmcnt(" #n ")" ::: "memory")
#define PG8_BAR __builtin_amdgcn_s_barrier()
#define PG8_SCHED __builtin_amdgcn_sched_barrier(0)
    Unit cur, nxt; int ui = 0;
    if (!S.next(0, cur)) return;
    f32x4 acc[2][2][4][2];
#pragma unroll
    for (int a = 0; a < 2; ++a)
#pragma unroll
        for (int b = 0; b < 2; ++b)
#pragma unroll
            for (int m = 0; m < 4; ++m)
#pragma unroll
                for (int n = 0; n < 2; ++n) acc[a][b][m][n] = (f32x4){0.f, 0.f, 0.f, 0.f};
    bf16x8 At[4][2], B0[2][2], B1[2][2];
    const char* cA = (const char*)g.A + (size_t)cur.pm * tstep; const char* cB = (const char*)g.Bt + (size_t)cur.pn * tstep;
    S.a_ready(cur);
    if constexpr (SP2) {
        PG8_STAGE(PG8_SB(0, 0), cB, voffB); PG8_STAGE(PG8_SB(0, 1), cB + hstep, voffB); PG8_STAGE(PG8_SA(0, 0), cA, voffA); PG8_STAGE(PG8_SA(0, 1), cA + hstep, voffA);
        if (wr == 1) PG8_BAR;
        PG8_WAIT_V(2); PG8_BAR;
        PG8_STAGE(PG8_SB(1, 0), cB + kstep, voffB); PG8_STAGE(PG8_SA(1, 0), cA + kstep, voffA); PG8_STAGE(PG8_SB(1, 1), cB + hstep + kstep, voffB);
        PG8_WAIT_V(6); PG8_BAR;
    } else {
        PG8_STAGE(PG8_SB(0, 0), cB, voffB); PG8_STAGE(PG8_SA(0, 0), cA, voffA); PG8_STAGE(PG8_SB(0, 1), cB + hstep, voffB); PG8_STAGE(PG8_SA(0, 1), cA + hstep, voffA);
        if (wr == 1) PG8_BAR;
        PG8_WAIT_V(4); PG8_BAR;
        PG8_STAGE(PG8_SB(1, 0), cB + kstep, voffB); PG8_STAGE(PG8_SA(1, 0), cA + kstep, voffA); PG8_STAGE(PG8_SB(1, 1), cB + hstep + kstep, voffB);
        PG8_WAIT_V(6); PG8_BAR;
    }
    for (;;) {
        const bool has_next = S.next(ui + 1, nxt);
        const char* nA = has_next ? (const char*)g.A + (size_t)nxt.pm * tstep : cA; const char* nB = has_next ? (const char*)g.Bt + (size_t)nxt.pn * tstep : cB;
        for (int t = 0; t < nt; t += 2) {
            const bool last = (t == nt - 2);
            const char* a1 = cA + (size_t)(t + 1) * kstep;
            const char* a2 = last ? nA : cA + (size_t)(t + 2) * kstep; const char* b2 = last ? nB : cB + (size_t)(t + 2) * kstep;
            const char* a3 = a2 + kstep; const char* b3 = b2 + kstep;
            if (last && has_next) S.a_ready(nxt);
            if constexpr (SP2) {
            PG8_LDB(B0, 0, 0); PG8_LDB(B1, 0, 1); PG8_SCHED; PG8_LDA(At, 0, 0); PG8_STAGE(PG8_SA(1, 1), a1 + hstep, voffA);
            PG8_WAIT_V(8); PG8_WAIT_L(0); PG8_BAR; PG8_MMA(0, 0, At, B0); PG8_MMA(0, 1, At, B1); PG8_BAR; PG8_SCHED;
            PG8_LDA(At, 0, 1); PG8_STAGE(PG8_SB(0, 0), b2, voffB); PG8_STAGE(PG8_SB(0, 1), b2 + hstep, voffB); PG8_STAGE(PG8_SA(0, 0), a2, voffA);
            PG8_WAIT_V(8); PG8_WAIT_L(0); PG8_BAR; PG8_MMA(1, 0, At, B0); PG8_MMA(1, 1, At, B1); PG8_BAR; PG8_SCHED;
            PG8_LDB(B0, 1, 0); PG8_LDB(B1, 1, 1); PG8_SCHED; PG8_LDA(At, 1, 0); PG8_STAGE(PG8_SA(0, 1), a2 + hstep, voffA);
            PG8_WAIT_V(8); PG8_WAIT_L(0); PG8_BAR; PG8_MMA(0, 0, At, B0); PG8_MMA(0, 1, At, B1); PG8_BAR; PG8_SCHED;
            PG8_LDA(At, 1, 1); PG8_STAGE(PG8_SB(1, 0), b3, voffB); PG8_STAGE(PG8_SB(1, 1), b3 + hstep, voffB); PG8_STAGE(PG8_SA(1, 0), a3, voffA);
            PG8_WAIT_V(8); PG8_WAIT_L(0); PG8_BAR; PG8_MMA(1, 0, At, B0); PG8_MMA(1, 1, At, B1); PG8_BAR; PG8_SCHED;
            } else {
            PG8_LDB(B0, 0, 0); PG8_SCHED; PG8_LDA(At, 0, 0); PG8_STAGE(PG8_SA(1, 1), a1 + hstep, voffA);
            PG8_WAIT_L(8); PG8_BAR; PG8_WAIT_L(0); PG8_MMA(0, 0, At, B0); PG8_BAR; PG8_SCHED;
            PG8_LDB(B1, 0, 1); PG8_STAGE(PG8_SB(0, 0), b2, voffB);
            PG8_BAR; PG8_WAIT_L(0); PG8_MMA(0, 1, At, B1); PG8_BAR;
            PG8_LDA(At, 0, 1); PG8_STAGE(PG8_SA(0, 0), a2, voffA);
            PG8_BAR; PG8_WAIT_L(0); PG8_MMA(1, 0, At, B0); PG8_BAR; PG8_SCHED;
            PG8_STAGE(PG8_SB(0, 1), b2 + hstep, voffB);
            PG8_WAIT_V(6); PG8_BAR; PG8_MMA(1, 1, At, B1); PG8_BAR;
            PG8_LDB(B0, 1, 0); PG8_SCHED; PG8_LDA(At, 1, 0); PG8_STAGE(PG8_SA(0, 1), a2 + hstep, voffA);
            PG8_WAIT_L(8); PG8_BAR; PG8_WAIT_L(0); PG8_MMA(0, 0, At, B0); PG8_BAR; PG8_SCHED;
            PG8_LDB(B1, 1, 1); PG8_STAGE(PG8_SB(1, 0), b3, voffB);
            PG8_BAR; PG8_WAIT_L(0); PG8_MMA(0, 1, At, B1); PG8_BAR;
            PG8_LDA(At, 1, 1); PG8_STAGE(PG8_SA(1, 0), a3, voffA);
            PG8_BAR; PG8_WAIT_L(0); PG8_MMA(1, 0, At, B0); PG8_BAR; PG8_SCHED;
            PG8_STAGE(PG8_SB(1, 1), b3 + hstep, voffB);
            PG8_WAIT_V(6); PG8_BAR; PG8_MMA(1, 1, At, B1); PG8_BAR;
            }
        }
        if constexpr (ALIGN_EPI) { if (wr == 0) PG8_BAR; }
        if constexpr (!Epi::AFTER_DRAIN) { E(acc, cur, wr, wc, fr, fq); S.done(cur); }
        if (!has_next) break;
#pragma unroll
        for (int a = 0; a < 2; ++a)
#pragma unroll
            for (int b = 0; b < 2; ++b)
#pragma unroll
                for (int m = 0; m < 4; ++m)
#pragma unroll
                    for (int n = 0; n < 2; ++n) acc[a][b][m][n] = (f32x4){0.f, 0.f, 0.f, 0.f};
        cur = nxt; cA = nA; cB = nB; ++ui;
        if constexpr (ALIGN_EPI) { if (wr == 1) PG8_BAR; }
    }
    PG8_WAIT_V(0);
    if constexpr (!ALIGN_EPI) { if (wr == 0) PG8_BAR; }
    PG8_BAR;
    if constexpr (Epi::AFTER_DRAIN) { E.fused(acc, cur, wr, wc, fr, fq, lds, wid, lane); S.done(cur); }
#undef PG8_SA
#undef PG8_SB
#undef PG8_STAGE
#undef PG8_LDA
#undef PG8_LDB
#undef PG8_MMA
#undef PG8_WAIT_V
#undef PG8_WAIT_L
#undef PG8_BAR
#undef PG8_SCHED
}
}

template <int CTRL, int ROW_MASK = 0xf> __device__ __forceinline__ float dppf(float v) {
    return __builtin_bit_cast(float, __builtin_amdgcn_update_dpp(0, __builtin_bit_cast(int, v), CTRL, ROW_MASK, 0xf, false)); }
__device__ __forceinline__ float lanef(float v, int l) { return __builtin_bit_cast(float, __builtin_amdgcn_readlane(__builtin_bit_cast(int, v), l)); }
__device__ __forceinline__ float swap1f(float v) { return dppf<0xB1>(v); }
__device__ __forceinline__ float row16_sum(float v) { v += dppf<0xB1>(v); v += dppf<0x4E>(v); v += dppf<0x141>(v); v += dppf<0x140>(v); return v; }
__device__ __forceinline__ float row16_max(float v) { v = fmaxf(v, dppf<0xB1>(v)); v = fmaxf(v, dppf<0x4E>(v)); v = fmaxf(v, dppf<0x141>(v)); v = fmaxf(v, dppf<0x140>(v)); return v; }
__device__ __forceinline__ float wave_sum(float v) { v = row16_sum(v); return (lanef(v, 0) + lanef(v, 16)) + (lanef(v, 32) + lanef(v, 48)); }
__device__ __forceinline__ float wave_max_pos(float v) { v = row16_max(v); return fmaxf(fmaxf(lanef(v, 0), lanef(v, 16)), fmaxf(lanef(v, 32), lanef(v, 48))); }
__device__ __forceinline__ float wave_incl_scan(float v) {
    v += dppf<0x111>(v); v += dppf<0x112>(v); v += dppf<0x114>(v); v += dppf<0x118>(v);
    v += dppf<0x142, 0xA>(v);
    v += dppf<0x143, 0xC>(v);
    return v; }

namespace att {
typedef unsigned short bf16_t;
typedef short bf16x8 __attribute__((ext_vector_type(8)));
typedef short s16x4 __attribute__((ext_vector_type(4)));
typedef float f32x16 __attribute__((ext_vector_type(16)));
typedef float f32x4 __attribute__((ext_vector_type(4)));
typedef unsigned u32x4 __attribute__((ext_vector_type(4)));
constexpr int D = 128, RS = 4096;
constexpr int NW = 8, QBLK = 32, KVBLK = 64, QB = NW * QBLK;
constexpr int SHM_V = KVBLK * D * 2, SHM_K = KVBLK * D * 2;
constexpr int OFF_WS = 3 * SHM_V + 3 * SHM_K, OFF_KB = OFF_WS + NW * 64 * 4, OFF_JT = OFF_KB + 3 * 64 * 4, LDS_BYTES = OFF_JT + 64;
constexpr float SCALE = 0.08838834764831845f, LOG2E = 1.4426950408889634f, C2 = LOG2E * SCALE, THR2 = 30.f, SKIP_LOG2 = 41.f;

#define KSWZ(row, colB) ((row) * 256 + ((colB) ^ (((row) & 7) << 4)))
#define SBAR() __builtin_amdgcn_sched_barrier(0)
__device__ __forceinline__ int v_st(int k, int c) { const int kk = (k & ~0xC) | ((k & 4) << 1) | ((k & 8) >> 1); return ((kk >> 3) * 4 + (c >> 5)) * 512 + ((kk & 7) * 32 + (c & 31)) * 2; }
__device__ __forceinline__ int v_rd_base(int lane) { return ((lane & 3) << 3) | (((lane >> 2) & 3) << 6) | (((lane >> 4) & 1) << 5) | (((lane >> 5) & 1) << 8); }
constexpr int v_rd_off(int d0, int ks, int half) { return d0 * 512 + ks * 4096 + half * 2048; }
__device__ __forceinline__ int crow(int r, int hi) { return (r & 3) + 8 * (r >> 2) + 4 * hi; }
__device__ __forceinline__ unsigned cvtpk(float lo, float hi) { unsigned r; asm volatile("v_cvt_pk_bf16_f32 %0, %1, %2" : "=v"(r) : "v"(lo), "v"(hi)); return r; }
__device__ __forceinline__ bf16x8 ld8(const bf16_t* p) { return *reinterpret_cast<const bf16x8*>(p); }

__device__ __forceinline__ void mask_tile(f32x16& p0, f32x16& p1, int dq) {
    const float NEG = -__builtin_inff();
#pragma unroll
    for (int r = 0; r < 16; ++r) {
        const int c = (r & 3) + 8 * (r >> 2);
        if (dq - c < 0) p0[r] = NEG;
        if (dq - c - 32 < 0) p1[r] = NEG;
    }
}
__device__ __forceinline__ void mask_all(f32x16& p0, f32x16& p1) {
    const float NEG = -__builtin_inff();
#pragma unroll
    for (int r = 0; r < 16; ++r) { p0[r] = NEG; p1[r] = NEG; }
}
__device__ __forceinline__ void diag_fix(f32x16& p0, f32x16& p1, int dq, float slope2) {
    const float dqf = (float)dq, m2 = -2.f * slope2;
#pragma unroll
    for (int r = 0; r < 16; ++r) {
        const float c = (float)((r & 3) + 8 * (r >> 2));
        p0[r] = fmaf(fmaxf(c - dqf, 0.f), m2, p0[r]);
        p1[r] = fmaf(fmaxf(c + 32.f - dqf, 0.f), m2, p1[r]);
    }
}
__device__ __forceinline__ void add_bias(f32x16& p0, f32x16& p1, const float* kb) {
#pragma unroll
    for (int g = 0; g < 4; ++g) { const f32x4 b0 = *(const f32x4*)(kb + 8 * g), b1 = *(const f32x4*)(kb + 32 + 8 * g);
#pragma unroll
        for (int j = 0; j < 4; ++j) { p0[4 * g + j] = fmaf(p0[4 * g + j], C2, b0[j]); p1[4 * g + j] = fmaf(p1[4 * g + j], C2, b1[j]); } }
}
__device__ __forceinline__ void partialSM(f32x16& p0, f32x16& p1, float& m_reg, float& mn, float& alpha, bool& skp, int& nskip) {
    float pmax = p0[0];
#pragma unroll
    for (int r = 1; r < 16; ++r) pmax = fmaxf(pmax, p0[r]);
#pragma unroll
    for (int r = 0; r < 16; ++r) pmax = fmaxf(pmax, p1[r]);
    { auto rr = __builtin_amdgcn_permlane32_swap(__float_as_uint(pmax), __float_as_uint(pmax), false, false);
      pmax = fmaxf(__uint_as_float(rr[0]), __uint_as_float(rr[1])); }
    { const int L_ = nskip ? 32 - __builtin_clz((unsigned)nskip) : 0; skp = __all(pmax - m_reg < -(34.f + 2.f * (float)L_)); nskip += skp ? 1 : 0; }
    if (__builtin_expect(__all(pmax - m_reg <= THR2), 1)) { mn = m_reg; alpha = 1.f; }
    else { mn = fmaxf(m_reg, pmax); alpha = __builtin_amdgcn_exp2f(m_reg - mn); m_reg = mn; }
    if (skp) return;
#pragma unroll
    for (int r = 0; r < 16; ++r) { p0[r] = p0[r] - mn; p1[r] = p1[r] - mn; }
#pragma unroll
    for (int r = 0; r < 16; ++r) p0[r] = __builtin_amdgcn_exp2f(p0[r]);
}
__device__ __forceinline__ void finishSM(f32x16& p0, f32x16& p1, float alpha, float& l_reg, bf16x8& pa0, bf16x8& pa1, bf16x8& pa2, bf16x8& pa3) {
#pragma unroll
    for (int r = 0; r < 16; ++r) p1[r] = __builtin_amdgcn_exp2f(p1[r]);
    float ps = 0;
#pragma unroll
    for (int r = 0; r < 16; ++r) ps += p0[r];
#pragma unroll
    for (int r = 0; r < 16; ++r) ps += p1[r];
    { auto rr = __builtin_amdgcn_permlane32_swap(__float_as_uint(ps), __float_as_uint(ps), false, false);
      ps = __uint_as_float(rr[0]) + __uint_as_float(rr[1]); }
    l_reg = l_reg * alpha + ps;
#define PK4(P, B_, OUT) do { unsigned a0 = cvtpk(P[B_+0], P[B_+1]), a1 = cvtpk(P[B_+2], P[B_+3]);                          \
        unsigned b0 = cvtpk(P[B_+4], P[B_+5]), b1 = cvtpk(P[B_+6], P[B_+7]);                                             \
        auto r0 = __builtin_amdgcn_permlane32_swap(a0, b0, false, false); auto r1 = __builtin_amdgcn_permlane32_swap(a1, b1, false, false); \
        u32x4 w = {r0[0], r1[0], r0[1], r1[1]}; OUT = *reinterpret_cast<bf16x8*>(&w); } while (0)
    PK4(p0, 0, pa0); PK4(p0, 8, pa1); PK4(p1, 0, pa2); PK4(p1, 8, pa3);
#undef PK4
}
__device__ __forceinline__ void qkt(f32x16& p0, f32x16& p1, const char* K_buf, int r32, int hi, const bf16x8* qr) {
    p0 = f32x16{}; p1 = f32x16{};
    const char* kb[4];
#pragma unroll
    for (int dd = 0; dd < 4; ++dd) kb[dd] = K_buf + KSWZ(r32, (dd * 16 + hi * 8) * 2);
#pragma unroll
    for (int d0 = 0; d0 < 8; ++d0) { const char* a = kb[d0 & 3] + (d0 >> 2) * 128;
        bf16x8 b0 = *reinterpret_cast<const bf16x8*>(a);
        bf16x8 b1 = *reinterpret_cast<const bf16x8*>(a + 32 * 256);
        p0 = __builtin_amdgcn_mfma_f32_32x32x16_bf16(b0, qr[d0], p0, 0, 0, 0);
        p1 = __builtin_amdgcn_mfma_f32_32x32x16_bf16(b1, qr[d0], p1, 0, 0, 0); }
}
template <int VB>
__device__ __forceinline__ void pv_tile(f32x16* o, int vb0, bf16x8 pa0, bf16x8 pa1, bf16x8 pa2, bf16x8 pa3) {
#define TRRD(dst, off) asm volatile("ds_read_b64_tr_b16 %0, %1 offset:%2" : "=&v"(dst) : "v"(vb0), "i"(off) : "memory")
#define PV_D0(d0) do { s16x4 l0, l1, l2, l3, h0, h1, h2, h3; constexpr int b_ = VB * SHM_V + v_rd_off(d0, 0, 0);     \
        TRRD(l0, b_); TRRD(h0, b_ + 2048); TRRD(l1, b_ + 4096); TRRD(h1, b_ + 6144); TRRD(l2, b_ + 8192); TRRD(h2, b_ + 10240); TRRD(l3, b_ + 12288); TRRD(h3, b_ + 14336); \
        asm volatile("s_waitcnt lgkmcnt(0)" ::: "memory"); SBAR();                 \
        o[d0] = __builtin_amdgcn_mfma_f32_32x32x16_bf16(pa0, (bf16x8){l0[0], l0[1], l0[2], l0[3], h0[0], h0[1], h0[2], h0[3]}, o[d0], 0, 0, 0);   \
        o[d0] = __builtin_amdgcn_mfma_f32_32x32x16_bf16(pa1, (bf16x8){l1[0], l1[1], l1[2], l1[3], h1[0], h1[1], h1[2], h1[3]}, o[d0], 0, 0, 0);   \
        o[d0] = __builtin_amdgcn_mfma_f32_32x32x16_bf16(pa2, (bf16x8){l2[0], l2[1], l2[2], l2[3], h2[0], h2[1], h2[2], h2[3]}, o[d0], 0, 0, 0);   \
        o[d0] = __builtin_amdgcn_mfma_f32_32x32x16_bf16(pa3, (bf16x8){l3[0], l3[1], l3[2], l3[3], h3[0], h3[1], h3[2], h3[3]}, o[d0], 0, 0, 0); } while (0)
    PV_D0(0); PV_D0(1); PV_D0(2); PV_D0(3);
#undef PV_D0
#undef TRRD
}

template <class T> struct IS_F16 { static constexpr bool v = false; };
template <> struct IS_F16<_Float16> { static constexpr bool v = true; };
template <class TOut> struct BlockRef { const bf16_t* Q; const bf16_t* K; const bf16_t* V; TOut* O; const float* KBs; float slope2; int P0, jlo; };
struct Seam { bf16x8 qr[8]; };
typedef __attribute__((address_space(3))) unsigned las_u32;
#define VMW() asm volatile("s_waitcnt vmcnt(0)" ::: "memory")
#define VMWN(n) asm volatile("s_waitcnt vmcnt(%0)" :: "i"(n) : "memory")
#define ABAR() do { asm volatile("s_waitcnt lgkmcnt(0)" ::: "memory"); __builtin_amdgcn_s_barrier(); asm volatile("" ::: "memory"); } while (0)
#define LDSP(off) ((las_u32*)(uintptr_t)(lbase + (unsigned)(off)))
#define DMA_K_(Kp, KBp, sl2, P0v, k0, bf) do { const char* g_ = (const char*)(Kp) + (size_t)(k0) * (RS * 2) + koff; const unsigned lo_ = 3 * SHM_V + (unsigned)(bf) * SHM_K + wid * 1024; \
        __builtin_amdgcn_global_load_lds((const unsigned*)g_, LDSP(lo_), 16, 0, 0);                                                                              \
        __builtin_amdgcn_global_load_lds((const unsigned*)(g_ + 32 * RS * 2), LDSP(lo_ + 8192), 16, 0, 0);                                                       \
          \
                             \
        if (MODE == 0) __builtin_amdgcn_global_load_lds((const unsigned*)((KBp) + (k0) + lane), LDSP(OFF_KB + (unsigned)(bf) * 256), 4, 0, 0);                        \
        else { int d_ = (k0) - (P0v); asm volatile("" : "+s"(d_)); if (tid < 64) kb_l[(bf) * 64 + tid] = (sl2) * (float)(d_ + lane); } } while (0)
#define DMA_K(R, k0, bf) DMA_K_((R).K, (R).KBs, (R).slope2, (R).P0, k0, bf)
#define DMA_V(R, k0, bf) do { const char* g_ = (const char*)(R).V + (size_t)(k0) * (RS * 2) + voff; const unsigned lv_ = (unsigned)(bf) * SHM_V + wid * 2048;            \
        __builtin_amdgcn_global_load_lds((const unsigned*)g_, LDSP(lv_), 16, 0, 0);                                                                               \
        __builtin_amdgcn_global_load_lds((const unsigned*)(g_ + 128), LDSP(lv_ + 1024), 16, 0, 0); } while (0)
#define DMA_OFFS() const unsigned lbase = (unsigned)(uintptr_t)lds;                                                                                              \
        const int krow_ = 4 * wid + (lane >> 4), kk_ = 8 * wid + ((lane & 31) >> 2), vk_ = (kk_ & ~0xC) | ((kk_ & 4) << 1) | ((kk_ & 8) >> 1);                  \
        const unsigned koff = (unsigned)(krow_ * RS + (((lane & 15) ^ (krow_ & 7)) * 8)) * 2u, voff = (unsigned)(vk_ * RS + (lane >> 5) * 32 + (lane & 3) * 8) * 2u
constexpr int NBL(int mode) { return mode == 0 ? 1 : 0; }
template <int MODE, class TOut>
__device__ __forceinline__ void attn_prime(const BlockRef<TOut>& cur, char* lds, Seam& S, const int tid) {
    const int wid = __builtin_amdgcn_readfirstlane(tid >> 6), lane = tid & 63, r32 = lane & 31, hi = lane >> 5;
    float* kb_l = (float*)(lds + OFF_KB);
    DMA_OFFS();
#pragma unroll
    for (int d0 = 0; d0 < 8; ++d0) S.qr[d0] = ld8(cur.Q + (size_t)(wid * QBLK + r32) * RS + d0 * 16 + hi * 8);
    DMA_K(cur, cur.P0 + 3 * KVBLK, 0); DMA_V(cur, cur.P0 + 3 * KVBLK, 0);
    DMA_K(cur, cur.P0 + 2 * KVBLK, 1);
    VMW();
    ABAR();
}
template <int MODE, class TOut, int OS>
__device__ __forceinline__ void attn_block(const BlockRef<TOut>& cur, const BlockRef<TOut>& nxt, char* lds, Seam& S, const int tid, int& kph) {
    const int wid = __builtin_amdgcn_readfirstlane(tid >> 6), lane = tid & 63, r32 = lane & 31, hi = lane >> 5;
    const int NT = cur.P0 / KVBLK + 4 - cur.jlo;
    const int qlo = cur.P0 + wid * QBLK, qm = qlo + r32 - 4 * hi;
    char* V_lds = lds; char* K_lds = lds + 3 * SHM_V; float* kb_l = (float*)(lds + OFF_KB);
    float* ws = (float*)(lds + OFF_WS) + wid * 64; float* li_l = ws, * al_l = ws + 32;
    float m_reg = -1e30f, l_reg = 0; f32x16 o[4] = {}; int nskip = 0;
    DMA_OFFS();
    const int vb0 = (int)(uintptr_t)V_lds + v_rd_base(lane);
#define RESC(a) do { if (__any((a) < 1.f)) { if (hi == 0) al_l[r32] = (a); asm volatile("s_waitcnt lgkmcnt(0)" ::: "memory");              \
                     for (int d_ = 0; d_ < 4; ++d_) for (int r = 0; r < 16; ++r) o[d_][r] *= al_l[crow(r, hi)]; } } while (0)
#define KBASE(t) (cur.P0 + (3 - (t)) * KVBLK)
#define BIASMASK(P0_, P1_, t, KB) do { add_bias(P0_, P1_, kb_l + (KB) * 64 + 4 * hi); const int kb_ = KBASE(t);                               \
        if (MODE == 0) { if (kb_ + KVBLK - 1 > qlo) mask_tile(P0_, P1_, qm - kb_); }                                                         \
        else { const int ct_ = qlo >> 6, tj_ = kb_ >> 6; if (tj_ > ct_) mask_all(P0_, P1_); else if (tj_ == ct_) diag_fix(P0_, P1_, qm - kb_, cur.slope2); } } while (0)
    constexpr int NQL = 8, NB = NBL(MODE);
    f32x16 pA0, pA1, pB0, pB1; float mnA, mnB, alA, alB; bf16x8 pa0, pa1, pa2, pa3; bool skA, skB;
    int k0_ = kph, k1_ = kph + 1 == 3 ? 0 : kph + 1, k2_ = k1_ + 1 == 3 ? 0 : k1_ + 1;
#define KROT() do { const int t_ = k0_; k0_ = k1_; k1_ = k2_; k2_ = t_; } while (0)
#define KBUF(b) (K_lds + (b) * SHM_K)
#define VBUF(b) (vb0 + (b) * SHM_V)
    SBAR(); qkt(pA0, pA1, KBUF(k0_), r32, hi, S.qr); SBAR();
    DMA_K(cur, KBASE(2), k2_); DMA_V(cur, KBASE(1), k1_); SBAR();
    BIASMASK(pA0, pA1, 0, k0_); partialSM(pA0, pA1, m_reg, mnA, alA, skA, nskip);
    VMWN(4 + NB);
    ABAR(); KROT();
#define HALF_STEP(PX0, PX1, mnX, alX, skX, PY0, PY1, alY, skY, t) do {                                                                  \
        SBAR(); { const bool nx_ = (t) + 2 >= NT; DMA_K_(nx_ ? nxt.K : cur.K, nx_ ? nxt.KBs : cur.KBs, nx_ ? nxt.slope2 : cur.slope2, nx_ ? nxt.P0 : cur.P0,             \
                                                       nx_ ? nxt.P0 + 3 * KVBLK : KBASE((t) + 2), k2_); } DMA_V(cur, KBASE((t) + 1), k1_); SBAR();  \
        qkt(PX0, PX1, KBUF(k0_), r32, hi, S.qr);                                                                              \
        if (!(skY)) finishSM(PY0, PY1, alY, l_reg, pa0, pa1, pa2, pa3); SBAR();                                               \
        if (!(skY)) pv_tile<0>(o, VBUF(k2_), pa0, pa1, pa2, pa3); BIASMASK(PX0, PX1, (t), k0_); partialSM(PX0, PX1, m_reg, mnX, alX, skX, nskip); \
        VMWN(4 + NB); RESC(alX); ABAR(); KROT(); } while (0)
    for (int t = 1; t + 1 < NT; t += 2) {
        HALF_STEP(pB0, pB1, mnB, alB, skB, pA0, pA1, alA, skA, t);
        HALF_STEP(pA0, pA1, mnA, alA, skA, pB0, pB1, alB, skB, t + 1);
    }
    SBAR(); qkt(pB0, pB1, KBUF(k0_), r32, hi, S.qr); SBAR();
    DMA_K(nxt, nxt.P0 + 2 * KVBLK, k2_); DMA_V(nxt, nxt.P0 + 3 * KVBLK, k1_); SBAR();
#pragma unroll
    for (int d0 = 0; d0 < 8; ++d0) S.qr[d0] = ld8(nxt.Q + (size_t)(wid * QBLK + r32) * RS + d0 * 16 + hi * 8);
    SBAR();
    if (!skA) finishSM(pA0, pA1, alA, l_reg, pa0, pa1, pa2, pa3); SBAR();
    if (!skA) pv_tile<0>(o, VBUF(k2_), pa0, pa1, pa2, pa3);
    BIASMASK(pB0, pB1, NT - 1, k0_); partialSM(pB0, pB1, m_reg, mnB, alB, skB, nskip);
    VMWN(4 + NB + NQL);
    ABAR(); RESC(alB);
    if (!skB) { finishSM(pB0, pB1, alB, l_reg, pa0, pa1, pa2, pa3); SBAR(); pv_tile<0>(o, VBUF(k0_), pa0, pa1, pa2, pa3); }
    SBAR(); kph = k1_;
    if (hi == 0) li_l[r32] = l_reg; asm volatile("s_waitcnt lgkmcnt(0)" ::: "memory");
    float rli[16];
#pragma unroll
    for (int r = 0; r < 16; ++r) rli[r] = __builtin_amdgcn_rcpf(li_l[crow(r, hi)]);
    TOut* Ow = cur.O + (size_t)(wid * QBLK) * OS;
#pragma unroll
    for (int r = 0; r < 16; ++r) { const int orow = crow(r, hi);
#pragma unroll
        for (int d0 = 0; d0 < 4; ++d0) { const float v = o[d0][r] * rli[r];
            if constexpr (sizeof(TOut) == 4) { Ow[(size_t)orow * OS + d0 * 32 + r32] = v; }
            else { const float vn = swap1f(v);
                   if ((r32 & 1) == 0) { unsigned pk_;
                       if constexpr (IS_F16<TOut>::v) { typedef _Float16 h2_ __attribute__((ext_vector_type(2))); const h2_ hh = {(_Float16)v, (_Float16)vn}; pk_ = __builtin_bit_cast(unsigned, hh); }
                       else pk_ = cvtpk(v, vn);
                       *(unsigned*)(Ow + (size_t)orow * OS + d0 * 32 + r32) = pk_; } } } }
    ABAR();
#undef RESC
#undef KBASE
#undef BIASMASK
#undef HALF_STEP
#undef KROT
#undef KBUF
#undef VBUF
}
#undef VMW
#undef VMWN
#undef LDSP
#undef ABAR
#undef DMA_K
#undef DMA_K_
#undef DMA_V
#undef DMA_OFFS

struct AttnCfg { const bf16_t* Q; const bf16_t* K; const bf16_t* V; void* O; const float* KBs; const float* QN; const float* KN; const float* DG; };
__device__ const unsigned short DIFF_TAB[1024] = {1001, 904, 864, 796, 728, 608, 557, 529, 499, 347, 327, 275, 212, 158, 109, 44, 1002, 968, 865, 797, 729, 609, 558, 530, 500, 348, 328, 276, 213, 159, 110, 45, 1003, 866, 798, 730, 713, 704, 605, 553, 525, 491, 442, 300, 264, 237, 188, 75, 1004, 867, 799, 731, 712, 622, 589, 489, 457, 437, 291, 259, 228, 177, 63, 0, 1005, 901, 868, 800, 732, 711, 708, 515, 411, 393, 368, 318, 164, 141, 115, 50, 1006, 965, 869, 801, 775, 772, 733, 475, 451, 416, 373, 246, 196, 87, 22, 5, 1007, 870, 839, 802, 734, 612, 582, 568, 407, 389, 364, 314, 155, 136, 106, 41, 1008, 903, 871, 803, 735, 613, 583, 569, 408, 390, 365, 315, 156, 137, 107, 42, 1009, 967, 872, 804, 736, 614, 584, 570, 409, 391, 366, 316, 157, 138, 108, 43, 1010, 873, 805, 737, 710, 687, 637, 511, 472, 361, 341, 290, 227, 176, 127, 62, 1011, 874, 806, 774, 738, 688, 638, 514, 473, 422, 380, 203, 144, 130, 82, 17, 1012, 875, 838, 807, 739, 689, 639, 578, 474, 423, 381, 204, 145, 131, 83, 18, 1013, 902, 876, 808, 740, 705, 690, 581, 485, 455, 431, 306, 243, 84, 19, 2, 1014, 966, 963, 877, 809, 741, 691, 644, 404, 350, 330, 278, 215, 161, 112, 47, 1015, 878, 810, 742, 678, 648, 628, 502, 463, 352, 332, 281, 218, 167, 118, 53, 1016, 879, 811, 743, 679, 649, 629, 503, 464, 353, 333, 282, 219, 168, 119, 54, 1017, 880, 812, 744, 680, 650, 630, 504, 465, 354, 334, 283, 220, 169, 120, 55, 1018, 881, 813, 745, 681, 651, 631, 505, 466, 355, 335, 284, 221, 170, 121, 56, 1019, 882, 814, 746, 682, 652, 632, 506, 467, 356, 336, 285, 222, 171, 122, 57, 1020, 883, 815, 747, 683, 653, 633, 507, 468, 357, 337, 286, 223, 172, 123, 58, 1021, 884, 816, 748, 684, 654, 634, 508, 469, 358, 338, 287, 224, 173, 124, 59, 1022, 885, 817, 749, 685, 655, 635, 509, 470, 359, 339, 288, 225, 174, 125, 60, 1023, 886, 818, 750, 686, 656, 636, 510, 471, 360, 340, 289, 226, 175, 126, 61, 1000, 863, 795, 767, 727, 706, 610, 560, 532, 438, 292, 260, 229, 178, 65, 64, 999, 862, 794, 758, 722, 596, 580, 579, 412, 394, 369, 319, 179, 142, 128, 66, 998, 861, 841, 793, 760, 598, 545, 517, 480, 426, 385, 293, 230, 192, 180, 67, 997, 860, 842, 833, 792, 776, 603, 550, 522, 486, 433, 309, 252, 95, 30, 11, 996, 859, 791, 782, 676, 643, 616, 586, 424, 398, 382, 205, 146, 132, 88, 23, 995, 858, 830, 790, 675, 615, 585, 571, 410, 392, 367, 317, 162, 139, 113, 48, 994, 857, 828, 789, 703, 668, 575, 543, 425, 399, 383, 206, 147, 133, 89, 24, 993, 961, 856, 845, 831, 707, 677, 617, 587, 435, 400, 311, 255, 100, 35, 14, 992, 960, 910, 906, 855, 840, 606, 554, 526, 492, 446, 304, 268, 241, 193, 79, 991, 975, 854, 754, 718, 625, 592, 496, 460, 343, 323, 271, 208, 149, 98, 33, 990, 853, 848, 777, 759, 597, 576, 544, 516, 479, 420, 378, 257, 201, 186, 73, 989, 977, 850, 764, 726, 641, 602, 549, 521, 484, 430, 305, 242, 81, 16, 1, 988, 913, 895, 763, 725, 640, 601, 577, 548, 520, 483, 429, 299, 236, 187, 74, 987, 978, 852, 755, 719, 626, 593, 497, 461, 344, 324, 272, 209, 150, 101, 36, 986, 914, 899, 890, 780, 773, 673, 620, 403, 349, 329, 277, 214, 160, 111, 46, 985, 979, 891, 779, 693, 658, 556, 528, 498, 346, 326, 274, 211, 154, 105, 40, 984, 915, 887, 835, 829, 709, 672, 619, 402, 345, 325, 273, 210, 153, 104, 39, 949, 925, 909, 837, 781, 674, 627, 501, 462, 351, 331, 279, 216, 165, 116, 51, 973, 950, 926, 843, 769, 669, 647, 642, 559, 531, 432, 308, 250, 93, 28, 9, 951, 927, 844, 825, 700, 665, 572, 540, 413, 395, 370, 321, 163, 140, 114, 49, 952, 928, 908, 826, 701, 666, 573, 541, 414, 396, 371, 244, 194, 85, 20, 3, 972, 953, 929, 827, 702, 667, 574, 542, 415, 397, 372, 245, 195, 86, 21, 4, 954, 930, 834, 819, 783, 768, 694, 659, 562, 534, 443, 301, 265, 238, 189, 76, 955, 931, 898, 832, 820, 784, 695, 660, 563, 535, 444, 302, 266, 239, 190, 77, 962, 956, 932, 896, 821, 785, 696, 661, 564, 536, 445, 303, 267, 240, 191, 78, 957, 933, 822, 786, 697, 662, 565, 537, 450, 421, 379, 202, 143, 129, 80, 15, 958, 934, 823, 787, 698, 663, 566, 538, 405, 387, 362, 312, 151, 134, 102, 37, 959, 935, 824, 788, 699, 664, 567, 539, 406, 388, 363, 313, 152, 135, 103, 38, 974, 970, 936, 924, 692, 657, 552, 524, 490, 439, 320, 295, 261, 232, 182, 69, 937, 923, 846, 778, 770, 714, 611, 561, 533, 440, 384, 296, 262, 233, 183, 70, 983, 938, 847, 751, 715, 621, 588, 488, 456, 436, 280, 258, 217, 166, 117, 52, 969, 939, 922, 911, 766, 607, 555, 527, 495, 342, 322, 270, 207, 148, 96, 31, 940, 921, 849, 752, 716, 623, 590, 493, 458, 447, 307, 269, 248, 91, 26, 7, 982, 976, 941, 762, 724, 600, 547, 519, 513, 512, 482, 428, 298, 235, 185, 72, 942, 920, 912, 900, 757, 721, 595, 477, 453, 418, 376, 251, 199, 94, 29, 10, 943, 919, 851, 753, 717, 624, 591, 494, 459, 386, 374, 247, 197, 90, 25, 6, 944, 918, 894, 761, 723, 599, 546, 518, 481, 449, 427, 294, 256, 231, 181, 68, 981, 945, 893, 836, 756, 720, 594, 476, 452, 417, 375, 249, 198, 92, 27, 8, 946, 917, 905, 897, 892, 765, 604, 551, 523, 487, 434, 310, 253, 97, 32, 12, 964, 947, 916, 907, 888, 670, 646, 478, 454, 419, 377, 254, 200, 99, 34, 13, 980, 971, 948, 889, 771, 671, 645, 618, 448, 441, 401, 297, 263, 234, 184, 71};
template <int MODE> __device__ __forceinline__ bool attn_item(int i, int G, int bx, int& vh, int& qb) {
    constexpr int NVH = MODE == 0 ? 32 : 64;
    if (G == 256) {
        if (MODE == 0) { if (i >= 8) return false; vh = (bx & 7) * 4 + (i >> 1); qb = (i & 1) ? 63 - (bx >> 3) : (bx >> 3); return true; }
        if (i >= 16) return false;
        const unsigned e = DIFF_TAB[(bx >> 2) * 16 + i];
        vh = (int)(e >> 6) * 4 + (bx & 3); qb = (int)(e & 63u); return true;
    }
    const long L = (long)i * G + bx; if (L >= (long)NVH * 64) return false; vh = (int)(L >> 6); qb = (int)(L & 63); return true;
}
template <int MODE> __device__ __forceinline__ int attn_jlo(const AttnCfg& c, int hm, int qb, const float* nd2, float slope2, int lane) {
    const float kn = wave_max_pos(lane <= qb ? c.KN[lane * 32 + hm] : 0.f), qn = c.QN[qb * 32 + hm];
    const float skip = 28.f + __builtin_amdgcn_logf(1.0f / (1.0f - __builtin_amdgcn_exp2f(-(MODE == 0 ? 1.0f : slope2))));
    const float B = C2 * sqrtf(qn * kn) * 1.0001f, Lb = C2 * c.DG[qb * 32 + hm], thr = B - Lb + skip;
    const int jd = qb * 4;
    int jlo;
    if (MODE == 0) {
        const float ref0 = nd2[qb * QB], tau = __builtin_amdgcn_exp2f(-(27.f + 6.f + 0.5f) - (B - Lb)); float carry = 0.f; jlo = 0;
#pragma unroll
        for (int cc = 0; cc < 4; ++cc) { const int jj = lane + 64 * cc; const float x = (jj < jd) ? __builtin_amdgcn_exp2f(nd2[jj * KVBLK + KVBLK - 1] - ref0) : 0.f;
            const float incl = wave_incl_scan(x) + carry, excl = incl - x; carry = lanef(incl, 63);
            const unsigned long long bal = __ballot(jj <= jd && excl < tau); if (bal) { const int f = 63 - __builtin_clzll(bal) + 64 * cc; jlo = f > jlo ? f : jlo; } }
    } else {
        const float w = thr / slope2; const float jf = floorf(((float)(qb * QB - (KVBLK - 1)) - w) * (1.f / KVBLK)) - 1.f;
        jlo = jf < 0.f ? 0 : (jf > (float)jd ? jd : (int)jf);
    }
    jlo = __builtin_amdgcn_readfirstlane(jlo) & ~1;
    return jlo < jd ? jlo : jd;
}
template <int MODE> __device__ __forceinline__ int attn_jlo_vh(const AttnCfg& c, int vh, int qb, int lane) {
    if (MODE == 0) return attn_jlo<0>(c, vh, qb, c.KBs + (size_t)vh * 16384, 0.f, lane);
    return attn_jlo<1>(c, vh >> 1, qb, nullptr, __builtin_amdgcn_exp2f(-0.5f * (float)((vh >> 2) + 1)) * LOG2E, lane);
}
template <int MODE, class TOut> __device__ __forceinline__ BlockRef<TOut> attn_ref(const AttnCfg& c, int vh, int qb, int lane, int jlo_known) {
    BlockRef<TOut> r; const size_t row0 = (size_t)qb * QB; r.P0 = qb * QB;
    if (MODE == 0) {
        r.Q = c.Q + row0 * RS + vh * D; r.K = c.K + vh * D; r.V = c.V + vh * D; r.O = (TOut*)c.O + row0 * 4096 + vh * D; r.KBs = c.KBs + (size_t)vh * 16384; r.slope2 = 0.f;
        r.jlo = jlo_known;
    } else {
        const int h = vh >> 2, mp = (vh >> 1) & 1, vhf = vh & 1;
        r.Q = c.Q + row0 * RS + h * 256 + mp * D; r.K = c.K + h * 256 + mp * D; r.V = c.V + h * 256 + vhf * D; r.O = (TOut*)c.O + row0 * 8192 + vh * D; r.KBs = nullptr;
        r.slope2 = __builtin_amdgcn_exp2f(-0.5f * (float)(h + 1)) * LOG2E;
        r.jlo = jlo_known;
    }
    return r;
}
template <int MODE, class TOut, int OS>
__device__ __forceinline__ void attn_phase(char* lds, const AttnCfg& cfg, int G, int bx_, int wv) {
    int bx = bx_; asm volatile("" : "+s"(bx));
    int i = 0, vh, qb;
    if (!attn_item<MODE>(0, G, bx, vh, qb)) return;
    int* jt = (int*)(lds + OFF_JT);
    { const int tidp = tid_of(wv), lanep = tidp & 63, wid = __builtin_amdgcn_readfirstlane(tidp >> 6);
#pragma unroll
      for (int k = 0; k < 2; ++k) { const int it = wid * 2 + k; int vh_, qb_; if (attn_item<MODE>(it, G, bx, vh_, qb_)) { const int j_ = attn_jlo_vh<MODE>(cfg, vh_, qb_, lanep); if (lanep == 0) jt[it] = j_; } }
      __syncthreads(); }
    const int tid = tid_of(wv);
    const int lane = tid & 63;
    BlockRef<TOut> cur = attn_ref<MODE, TOut>(cfg, vh, qb, lane, __builtin_amdgcn_readfirstlane(jt[0]));
    Seam S;
    if (__builtin_amdgcn_readfirstlane(tid >> 6) >= 4) __builtin_amdgcn_s_setprio(3);
    attn_prime<MODE, TOut>(cur, lds, S, tid); int kph = 0;
    for (;;) {
        int vhn, qbn; const bool last = !attn_item<MODE>(i + 1, G, bx, vhn, qbn);
        const BlockRef<TOut> nxt = last ? cur : attn_ref<MODE, TOut>(cfg, vhn, qbn, lane, (i + 1 < 16) ? __builtin_amdgcn_readfirstlane(jt[(i + 1) & 15]) : 0);
        attn_block<MODE, TOut, OS>(cur, nxt, lds, S, tid, kph);
        if (last) break;
        cur = nxt; ++i;
    }
    __builtin_amdgcn_s_setprio(0);
}
}

constexpr int NWAVES = 8;
constexpr int SEQ = 16384, DM = 4096, DFF = 6144, DEPTH = 4, NA = 2, NB = 2;
constexpr int HA = 32, HB = 16, NQKVA = 3 * DM + HA;
constexpr float EPS = 1e-6f, LOG2E_F = 1.4426950408889634f;
constexpr size_t MiB = (size_t)1 << 20;
constexpr size_t WS_CTL = 0, CTL_ZERO_BYTES = 1 * MiB;
constexpr size_t WS_LOGF = 2 * MiB;
constexpr size_t WS_ND2 = 4 * MiB;
constexpr size_t WS_QN = 6 * MiB, WS_KN = 6 * MiB + 65536, WS_DG = 6 * MiB + 131072;
constexpr size_t WS_W1 = 8 * MiB, W1_SZ = 96 * MiB;
constexpr size_t WS_W2 = WS_W1 + 8 * W1_SZ, W2_SZ = 48 * MiB;
constexpr size_t WS_WAIN = WS_W2 + 8 * W2_SZ, WAIN_SZ = 97 * MiB;
constexpr size_t WS_WAOUT = WS_WAIN + 2 * WAIN_SZ, WSQ_SZ = 32 * MiB;
constexpr size_t WS_WKV = WS_WAOUT + 2 * WSQ_SZ;
constexpr size_t WS_WQB = WS_WKV + 64 * MiB;
constexpr size_t WS_WOB = WS_WQB + 2 * WSQ_SZ;
constexpr size_t WS_H = WS_WOB + 2 * WSQ_SZ;
constexpr size_t WS_HN = WS_H + 256 * MiB;
constexpr size_t WS_ACT = WS_HN + 128 * MiB;
constexpr size_t WS_Q = WS_ACT + 192 * MiB, WS_K = WS_Q + 128 * MiB, WS_V = WS_K + 128 * MiB;
constexpr size_t WS_ATT = WS_V + 128 * MiB;
constexpr size_t WS_KSH = WS_ATT + 128 * MiB, WS_VSH = WS_KSH + 128 * MiB;
constexpr size_t WS_OV = WS_VSH + 128 * MiB;
constexpr size_t WS_END = WS_OV + 512 * MiB;
constexpr int CW_TMO = 0;
constexpr int CW_BAR = 4096;
constexpr int RING_OFF = 0, RING_BYTES = 131072;
constexpr int LDSCTL_OFF = RING_BYTES, MISC_OFF = LDSCTL_OFF + 320;
constexpr int LDS_BYTES = 147456;
static_assert(MISC_OFF + 128 <= LDS_BYTES && att::LDS_BYTES <= RING_BYTES && pg8::STAGE_BYTES <= RING_BYTES, "LDS map");

#define GAS __attribute__((address_space(1)))
#define LAS __attribute__((address_space(3)))
typedef unsigned short bf16;
typedef unsigned v4u __attribute__((ext_vector_type(4)));
typedef unsigned v2u __attribute__((ext_vector_type(2)));
typedef float f32x4 __attribute__((ext_vector_type(4)));
typedef short bf16x8 __attribute__((ext_vector_type(8)));
#define LDS_WAIT() asm volatile("s_waitcnt lgkmcnt(0)" ::: "memory")
__device__ __forceinline__ unsigned f2bf(float f) { unsigned u = __builtin_bit_cast(unsigned, f); return (u + 0x7fffu + ((u >> 16) & 1u)) >> 16; }
__device__ __forceinline__ unsigned pk2(float lo, float hi) { return f2bf(lo) | (f2bf(hi) << 16); }

#define XB_TMO      128
#define XB_XCNT(j)  (256  + 64 * (j))
#define XB_XSUB(j)  (1280 + 64 * (j))
#define XB_XGEN(j)  (2304 + 64 * (j))
#define XB_TOP      3328
#define XB_TOPGEN   3392
#define XCD_BAR_WORDS 3456
#define XB_SPIN_CAP (1u << 22)

__device__ __forceinline__ unsigned xb_ld(unsigned* p)              { return __hip_atomic_load(p, __ATOMIC_RELAXED, __HIP_MEMORY_SCOPE_AGENT); }
__device__ __forceinline__ unsigned xb_add(unsigned* p, unsigned v) { return __hip_atomic_fetch_add(p, v, __ATOMIC_RELAXED, __HIP_MEMORY_SCOPE_AGENT); }
__device__ __forceinline__ unsigned xb_xcc_id() { return (unsigned)__builtin_amdgcn_s_getreg((3 << 11) | 20) & 0xFu; }
#define XB_SPIN(cond, bar) do { unsigned _sp = 0; while (cond) { __builtin_amdgcn_s_sleep(1); \
    if ((++_sp & 255u) == 0u) { if (xb_ld(&(bar)[XB_TMO])) break; if (_sp > XB_SPIN_CAP) { atomicAdd(&(bar)[XB_TMO], 1u); break; } } } } while (0)

struct XcdBarrier {
    unsigned* bar; unsigned x; int wv;
    volatile LAS unsigned* st;
};
__device__ __forceinline__ XcdBarrier xcd_barrier_post(unsigned* bar, volatile LAS unsigned* st, int wv) {
    XcdBarrier b; b.bar = bar; b.x = xb_xcc_id(); b.st = st; b.wv = wv;
    if (threadIdx.x == 0) (void)xb_add(&bar[XB_XCNT(b.x)], 1u);
    return b;
}
__device__ __forceinline__ void xcd_barrier_complete(unsigned* bar, unsigned x, unsigned& nloc, unsigned& nx) {
    const unsigned G = gridDim.x * gridDim.y * gridDim.z;
    unsigned sum, cnt, mine, sp = 0u;
    for (;;) {
        sum = 0u; cnt = 0u; mine = 0u;
#pragma unroll
        for (unsigned j = 0; j < 16; ++j) { const unsigned c = xb_ld(&bar[XB_XCNT(j)]); sum += c; cnt += (c > 0u) ? 1u : 0u; mine = (j == x) ? c : mine; }
        if (sum == G) break;
        __builtin_amdgcn_s_sleep(1);
        if ((++sp & 255u) == 0u) { if (xb_ld(&bar[XB_TMO])) break; if (sp > XB_SPIN_CAP) { atomicAdd(&bar[XB_TMO], 1u); break; } }
    }
    nloc = mine > 0u ? mine : 1u; nx = cnt > 0u ? cnt : 1u;
}
__device__ __forceinline__ void xcd_barrier(const XcdBarrier& b) {
    asm volatile("s_waitcnt vmcnt(0)" ::: "memory");
    __syncthreads();
    if (tid_of(b.wv) == 0) {
        unsigned* bar = b.bar;
        __builtin_amdgcn_s_waitcnt(0);
        unsigned nloc = b.st[0], nx = b.st[1];
        if (nloc == 0u) { xcd_barrier_complete(bar, b.x, nloc, nx); b.st[0] = nloc; b.st[1] = nx; }
        const unsigned old = xb_add(&bar[XB_XSUB(b.x)], 1u);
        const unsigned gen = old / nloc;
        if (old + 1u == (gen + 1u) * nloc) {
            __builtin_amdgcn_fence(__ATOMIC_RELEASE, "agent");
            asm volatile("s_waitcnt vmcnt(0)" ::: "memory");
            const unsigned og = xb_add(&bar[XB_TOP], 1u);
            const unsigned tg = og / nx;
            if (og + 1u == (tg + 1u) * nx) xb_add(&bar[XB_TOPGEN], 1u);
            else XB_SPIN(xb_ld(&bar[XB_TOPGEN]) == tg, bar);
            __builtin_amdgcn_fence(__ATOMIC_ACQUIRE, "agent");
            xb_add(&bar[XB_XGEN(b.x)], 1u);
            asm volatile("s_waitcnt vmcnt(0)" ::: "memory");
        } else {
            XB_SPIN(xb_ld(&bar[XB_XGEN(b.x)]) == gen, bar);
            __builtin_amdgcn_fence(__ATOMIC_ACQUIRE, "agent");
            asm volatile("s_waitcnt vmcnt(0)" ::: "memory");
        }
    }
    __syncthreads();
}

typedef float f32x4t __attribute__((ext_vector_type(4)));
struct TItem { const float* W; bf16* WT; int K, N, k0, n0, dest_row0; };
__device__ __forceinline__ void titem_load(const TItem& t, f32x4t (&r)[8], int lane) {
    const float* p = t.W + (size_t)(t.k0 + (lane >> 3)) * t.N + t.n0 + 4 * (lane & 7);
#pragma unroll
    for (int i = 0; i < 8; ++i) r[i] = *(const f32x4t*)(p + (size_t)(8 * i) * t.N);
}
__device__ __forceinline__ void titem_finish(const TItem& t, const f32x4t (&r)[8], LAS float* scr, int lane) {
    LAS float* w = scr + (lane >> 3) * 33 + 4 * (lane & 7);
#pragma unroll
    for (int i = 0; i < 8; ++i) { w[(8 * i) * 33 + 0] = r[i].x; w[(8 * i) * 33 + 1] = r[i].y; w[(8 * i) * 33 + 2] = r[i].z; w[(8 * i) * 33 + 3] = r[i].w; }
    LDS_WAIT(); asm volatile("" ::: "memory");
    const int c = lane & 7;
#pragma unroll
    for (int j = 0; j < 4; ++j) { const int n = (lane >> 3) + 8 * j; const LAS float* s = scr + (8 * c) * 33 + n;
        v4u o; o.x = pk2(s[0 * 33], s[1 * 33]); o.y = pk2(s[2 * 33], s[3 * 33]); o.z = pk2(s[4 * 33], s[5 * 33]); o.w = pk2(s[6 * 33], s[7 * 33]);
        *(v4u*)(t.WT + (size_t)(t.dest_row0 + n) * t.K + t.k0 + 8 * c) = o; }
    LDS_WAIT(); asm volatile("" ::: "memory");
}
struct Args { const float* in[15]; float* out; unsigned char* ws; int ph_lo, ph_hi; };
__device__ __forceinline__ void titem_decode(const __attribute__((address_space(4))) Args* ap, unsigned char* ws, int it, TItem& t) {
    constexpr int I_W1 = (DM / 64) * (2 * DFF / 32), I_W2 = (DFF / 64) * (DM / 32), I_AIN = (DM / 64) * (NQKVA / 32), I_SQ = (DM / 64) * (DM / 32), I_KV = (DM / 64) * (2 * DM / 32);
    constexpr int E0 = 8 * I_W1, E1 = E0 + 8 * I_W2, E2 = E1 + 2 * I_AIN, E3 = E2 + 2 * I_SQ, E4 = E3 + I_KV, E5 = E4 + 2 * I_SQ;
    int kb, nb;
    if (it < E0) {
        const int mi = it / I_W1, r = it % I_W1, nblk = 2 * DFF / 32; kb = r / nblk; nb = r % nblk; const int n0 = nb * 32, isup = n0 >= DFF, hid = n0 - isup * DFF;
        t.W = ap->in[2] + (size_t)mi * DM * 2 * DFF; t.K = DM; t.N = 2 * DFF; t.WT = (bf16*)(ws + WS_W1 + (size_t)mi * W1_SZ); t.dest_row0 = 256 * (hid >> 7) + 128 * isup + (hid & 127);
    } else if (it < E1) {
        const int q = it - E0, mi = q / I_W2, r = q % I_W2, nblk = DM / 32; kb = r / nblk; nb = r % nblk;
        t.W = ap->in[3] + (size_t)mi * DFF * DM; t.K = DFF; t.N = DM; t.WT = (bf16*)(ws + WS_W2 + (size_t)mi * W2_SZ); t.dest_row0 = nb * 32;
    } else if (it < E2) {
        const int q = it - E1, mi = q / I_AIN, r = q % I_AIN, nblk = NQKVA / 32; kb = r / nblk; nb = r % nblk;
        t.W = ap->in[5] + (size_t)mi * DM * NQKVA; t.K = DM; t.N = NQKVA; t.WT = (bf16*)(ws + WS_WAIN + (size_t)mi * WAIN_SZ); t.dest_row0 = nb * 32;
    } else if (it < E3) {
        const int q = it - E2, mi = q / I_SQ, r = q % I_SQ, nblk = DM / 32; kb = r / nblk; nb = r % nblk;
        t.W = ap->in[7] + (size_t)mi * DM * DM; t.K = DM; t.N = DM; t.WT = (bf16*)(ws + WS_WAOUT + (size_t)mi * WSQ_SZ); t.dest_row0 = nb * 32;
    } else if (it < E4) {
        const int r = it - E3, nblk = 2 * DM / 32; kb = r / nblk; nb = r % nblk;
        t.W = ap->in[9]; t.K = DM; t.N = 2 * DM; t.WT = (bf16*)(ws + WS_WKV); t.dest_row0 = nb * 32;
    } else if (it < E5) {
        const int q = it - E4, mi = q / I_SQ, r = q % I_SQ, nblk = DM / 32; kb = r / nblk; nb = r % nblk;
        t.W = ap->in[10] + (size_t)mi * DM * DM; t.K = DM; t.N = DM; t.WT = (bf16*)(ws + WS_WQB + (size_t)mi * WSQ_SZ); t.dest_row0 = nb * 32;
    } else {
        const int q = it - E5, mi = q / I_SQ, r = q % I_SQ, nblk = DM / 32; kb = r / nblk; nb = r % nblk;
        t.W = ap->in[13] + (size_t)mi * DM * DM; t.K = DM; t.N = DM; t.WT = (bf16*)(ws + WS_WOB + (size_t)mi * WSQ_SZ); t.dest_row0 = nb * 32;
    }
    t.k0 = 64 * kb; t.n0 = 32 * nb;
}
__device__ __forceinline__ void prologue_weights(const __attribute__((address_space(4))) Args* ap, LAS unsigned char* lds, int vcu, int G, int wv) {
    const int tid_ = tid_of(wv); const int lane = tid_ & 63, wave = __builtin_amdgcn_readfirstlane(tid_ >> 6), gw = vcu * NWAVES + wave, NGW = G * NWAVES; (void)wave; (void)gw; (void)NGW; (void)lane;
    LAS float* scr = (LAS float*)(lds + RING_OFF + wave * 16384);
    constexpr int I_W1 = (DM / 64) * (2 * DFF / 32), I_W2 = (DFF / 64) * (DM / 32), I_AIN = (DM / 64) * (NQKVA / 32), I_SQ = (DM / 64) * (DM / 32), I_KV = (DM / 64) * (2 * DM / 32);
    constexpr int E6 = 8 * I_W1 + 8 * I_W2 + 2 * I_AIN + 2 * I_SQ + I_KV + 2 * I_SQ + 2 * I_SQ;
    unsigned char* ws = ap->ws;
    int it = gw; if (it >= E6) return;
    TItem ta, tb; f32x4t ra[8], rb[8];
    titem_decode(ap, ws, it, ta); titem_load(ta, ra, lane);
    for (;;) {
        const int i1 = it + NGW; const bool h1 = i1 < E6; titem_decode(ap, ws, h1 ? i1 : it, tb); titem_load(tb, rb, lane);
        titem_finish(ta, ra, scr, lane);
        if (!h1) break;
        const int i2 = i1 + NGW; const bool h2 = i2 < E6; titem_decode(ap, ws, h2 ? i2 : i1, ta); titem_load(ta, ra, lane);
        titem_finish(tb, rb, scr, lane);
        if (!h2) break;
        it = i2;
    }
}
typedef _Float16 h16x8 __attribute__((ext_vector_type(8)));
template <bool OUT_F32, bool SRC16>
__device__ __forceinline__ void norm_phase(const void* src, const float* g, void* dst, LAS unsigned char* lds, int vcu, int G, int wv) {
    const int tid_ = tid_of(wv); const int lane = tid_ & 63, wave = __builtin_amdgcn_readfirstlane(tid_ >> 6), gw = vcu * NWAVES + wave, NGW = G * NWAVES;
#define NP_IDX(j) (SRC16 ? (2 * lane + 128 * ((j) >> 1) + ((j) & 1)) : (lane + 64 * (j)))
#define NP_LOAD(V, M) do { if (SRC16) { const h16x8* xr_ = (const h16x8*)((const _Float16*)src + (size_t)(M) * DM) + lane; _Pragma("unroll") for (int j = 0; j < 8; ++j) { const h16x8 c_ = xr_[64 * j]; \
            V[2 * j] = (f32x4){(float)c_[0], (float)c_[1], (float)c_[2], (float)c_[3]}; V[2 * j + 1] = (f32x4){(float)c_[4], (float)c_[5], (float)c_[6], (float)c_[7]}; } } \
        else { const f32x4* xr_ = (const f32x4*)((const float*)src + (size_t)(M) * DM); _Pragma("unroll") for (int j = 0; j < 16; ++j) V[j] = xr_[NP_IDX(j)]; } } while (0)
#define NP_PROC(V, M) do { float s_ = 0.f; _Pragma("unroll") for (int j = 0; j < 16; ++j) s_ += (V[j].x * V[j].x + V[j].y * V[j].y) + (V[j].z * V[j].z + V[j].w * V[j].w); \
        const float rstd_ = 1.0f / sqrtf(wave_sum(s_) * (1.f / DM) + EPS); \
        if (OUT_F32) { f32x4* o_ = (f32x4*)((float*)dst + (size_t)(M) * DM); _Pragma("unroll") for (int j = 0; j < 16; ++j) o_[NP_IDX(j)] = V[j] * rstd_ * gl[64 * j]; } \
        else { v2u* o_ = (v2u*)((bf16*)dst + (size_t)(M) * DM); _Pragma("unroll") for (int j = 0; j < 16; ++j) { const f32x4 y = V[j] * rstd_ * gl[64 * j]; v2u w; w.x = pk2(y.x, y.y); w.y = pk2(y.z, y.w); o_[NP_IDX(j)] = w; } } } while (0)
    { LAS f32x4* gs = (LAS f32x4*)(lds + RING_OFF);
#pragma unroll
      for (int r = 0; r < 2; ++r) { const int sl = tid_ + 512 * r, j = sl >> 6, l = sl & 63; gs[sl] = ((const f32x4*)g)[SRC16 ? (2 * l + 128 * (j >> 1) + (j & 1)) : (l + 64 * j)]; }
      __syncthreads(); }
    const LAS f32x4* gl = (const LAS f32x4*)(lds + RING_OFF) + lane;
    int m = gw; if (m >= SEQ) return;
    f32x4 va[16], vb[16];
    NP_LOAD(va, m);
    for (;;) {
        const int m1 = m + NGW; const bool h1 = m1 < SEQ; NP_LOAD(vb, (h1 ? m1 : m));
        NP_PROC(va, m);
        if (!h1) break;
        const int m2 = m1 + NGW; const bool h2 = m2 < SEQ; NP_LOAD(va, (h2 ? m2 : m1));
        NP_PROC(vb, m1);
        if (!h2) break;
        m = m2;
    }
#undef NP_LOAD
#undef NP_PROC
#undef NP_IDX
}
__device__ __forceinline__ void fgate_phase(const bf16* HN, const bf16* Wf, const float* bfv, float* LOGF, int vcu, int G, int wv) {
    const int tid_ = tid_of(wv); const int lane = tid_ & 63, wave = __builtin_amdgcn_readfirstlane(tid_ >> 6), gw = vcu * NWAVES + wave, NGW = G * NWAVES; (void)wave; (void)gw; (void)NGW; (void)lane;
    const int fr = lane & 15, fq = lane >> 4;
    for (int u = gw; u < SEQ / 16; u += NGW) {
        const int t0 = u * 16;
        f32x4 acc0 = {0.f, 0.f, 0.f, 0.f}, acc1 = {0.f, 0.f, 0.f, 0.f};
        const bf16* ap = HN + (size_t)(t0 + fr) * DM + fq * 8; const bf16* bp0 = Wf + (size_t)fr * DM + fq * 8; const bf16* bp1 = bp0 + (size_t)16 * DM;
#pragma unroll 8
        for (int k = 0; k < DM; k += 32) {
            const bf16x8 av = *(const bf16x8*)(ap + k), b0 = *(const bf16x8*)(bp0 + k), b1 = *(const bf16x8*)(bp1 + k);
            acc0 = __builtin_amdgcn_mfma_f32_16x16x32_bf16(av, b0, acc0, 0, 0, 0); acc1 = __builtin_amdgcn_mfma_f32_16x16x32_bf16(av, b1, acc1, 0, 0, 0);
        }
        const float c0 = bfv[fr], c1 = bfv[16 + fr]; f32x4 o0, o1;
#pragma unroll
        for (int j = 0; j < 4; ++j) { const float x0 = acc0[j] + c0, x1 = acc1[j] + c1;
            o0[j] = fminf(x0, 0.f) - log1pf(expf(-fabsf(x0))); o1[j] = fminf(x1, 0.f) - log1pf(expf(-fabsf(x1))); }
        *(f32x4*)(LOGF + (size_t)fr * SEQ + t0 + fq * 4) = o0; *(f32x4*)(LOGF + (size_t)(16 + fr) * SEQ + t0 + fq * 4) = o1;
    }
}
__device__ __forceinline__ void cumsum_phase(const float* LOGF, float* ND2, LAS unsigned char* lds, int vcu, int G, int wv) {
    const int tid_ = tid_of(wv); const int lane = tid_ & 63, wave = __builtin_amdgcn_readfirstlane(tid_ >> 6);
    static_assert(SEQ == NWAVES * 32 * 64, "cumsum_phase: 8 waves x 32 chunks x 64 lanes");
    volatile LAS float* tot = (volatile LAS float*)(lds + RING_OFF);
    for (int h = vcu; h < HA; h += G) {
        const float* src = LOGF + (size_t)h * SEQ + wave * 2048 + lane; float* dst = ND2 + (size_t)h * SEQ + wave * 2048 + lane;
        float x[32];
#pragma unroll
        for (int c = 0; c < 32; ++c) x[c] = src[c * 64];
        float carry = 0.f;
#pragma unroll
        for (int c = 0; c < 32; ++c) { const float v = wave_incl_scan(x[c]); x[c] = v + carry; carry += lanef(v, 63); }
        if (lane == 0) tot[wave] = carry;
        __syncthreads();
        float base = 0.f;
#pragma unroll
        for (int w = 0; w < NWAVES; ++w) { const float t = tot[w]; base += (w < wave) ? t : 0.f; }
#pragma unroll
        for (int c = 0; c < 32; ++c) dst[c * 64] = -LOG2E_F * (x[c] + base);
        __syncthreads();
    }
}
__device__ __forceinline__ void norms_phase(const bf16* Q, const bf16* K, float* QN, float* KN, float* DG, int vcu, int G, int wv) {
    const int tid_ = tid_of(wv); const int lane = tid_ & 63, wave = __builtin_amdgcn_readfirstlane(tid_ >> 6), gw = vcu * NWAVES + wave, NGW = G * NWAVES;
    for (int u = gw; u < 64 * 32; u += NGW) {
        const int qb = u >> 5, hm = u & 31; const size_t off = (size_t)(qb * 256 + (lane >> 4)) * DM + hm * 128 + (lane & 15) * 8;
        const bf16* pq = Q + off; const bf16* pk = K + off; float mq = 0.f, mk = 0.f, md = 3.0e38f;
#define TB_LOAD(WQ, WK, B) do { _Pragma("unroll") for (int i = 0; i < 8; ++i) { WQ[i] = *(const v4u*)(pq + (size_t)((B) * 8 + i) * 4 * DM); WK[i] = *(const v4u*)(pk + (size_t)((B) * 8 + i) * 4 * DM); } } while (0)
#define TB_PROC(WQ, WK) do { _Pragma("unroll") for (int i = 0; i < 8; ++i) { const v4u wq = WQ[i], wk = WK[i]; float sq = 0.f, sk = 0.f, sd = 0.f; \
            _Pragma("unroll") for (int q = 0; q < 4; ++q) { const unsigned uq = wq[q], uk = wk[q]; const float ql = __uint_as_float(uq << 16), qh = __uint_as_float(uq & 0xffff0000u), kl = __uint_as_float(uk << 16), kh = __uint_as_float(uk & 0xffff0000u); \
                sq = fmaf(ql, ql, sq); sq = fmaf(qh, qh, sq); sk = fmaf(kl, kl, sk); sk = fmaf(kh, kh, sk); sd = fmaf(ql, kl, sd); sd = fmaf(qh, kh, sd); } \
            sq = row16_sum(sq); sk = row16_sum(sk); sd = row16_sum(sd); mq = fmaxf(mq, sq); mk = fmaxf(mk, sk); md = fminf(md, sd); } } while (0)
        v4u qa[8], ka[8], qb2[8], kb2[8];
        TB_LOAD(qa, ka, 0);
#pragma unroll
        for (int b = 0; b < 8; b += 2) { TB_LOAD(qb2, kb2, b + 1); TB_PROC(qa, ka); if (b + 2 < 8) TB_LOAD(qa, ka, b + 2); TB_PROC(qb2, kb2); }
#undef TB_LOAD
#undef TB_PROC
        mq = fmaxf(fmaxf(lanef(mq, 0), lanef(mq, 16)), fmaxf(lanef(mq, 32), lanef(mq, 48))); mk = fmaxf(fmaxf(lanef(mk, 0), lanef(mk, 16)), fmaxf(lanef(mk, 32), lanef(mk, 48)));
        md = fminf(fminf(lanef(md, 0), lanef(md, 16)), fminf(lanef(md, 32), lanef(md, 48)));
        if (lane == 0) { QN[u] = mq; KN[u] = mk; DG[u] = md; }
    }
}
__device__ __forceinline__ void combine_phase(const _Float16* OV, const float* lamv, const float* gsub, float lam_init, bf16* ATT, int vcu, int G, int wv) {
    const int tid_ = tid_of(wv); const int lane = tid_ & 63, wave = __builtin_amdgcn_readfirstlane(tid_ >> 6), gw = vcu * NWAVES + wave, NGW = G * NWAVES;
    const float s1 = wave_sum(lamv[lane] * lamv[128 + lane] + lamv[64 + lane] * lamv[192 + lane]);
    const float s2 = wave_sum(lamv[256 + lane] * lamv[384 + lane] + lamv[320 + lane] * lamv[448 + lane]);
    const float lam = expf(s1) - expf(s2) + lam_init, post = 1.0f - lam_init;
    const f32x4 gv = ((const f32x4*)gsub)[lane];
    for (int it0 = gw; it0 < SEQ * HB; it0 += 8 * NGW) {
        typedef _Float16 h16x4 __attribute__((ext_vector_type(4)));
        h16x4 ha[8], hb[8];
#pragma unroll
        for (int k = 0; k < 8; ++k) { const int it_ = it0 + k * NGW, it = it_ < SEQ * HB ? it_ : it0, t = it >> 4, h = it & 15;
            ha[k] = ((const h16x4*)(OV + (size_t)t * 8192 + (size_t)(2 * h) * 256))[lane]; hb[k] = ((const h16x4*)(OV + (size_t)t * 8192 + (size_t)(2 * h + 1) * 256))[lane]; }
#pragma unroll
        for (int k = 0; k < 8; ++k) { const int it = it0 + k * NGW; if (it < SEQ * HB) { const int t = it >> 4, h = it & 15;
            const f32x4 a = {(float)ha[k][0], (float)ha[k][1], (float)ha[k][2], (float)ha[k][3]}, b = {(float)hb[k][0], (float)hb[k][1], (float)hb[k][2], (float)hb[k][3]};
            const f32x4 o = a - b * lam;
            const float rstd = 1.0f / sqrtf(wave_sum((o.x * o.x + o.y * o.y) + (o.z * o.z + o.w * o.w)) * (1.f / 256.f) + EPS);
            const f32x4 y = o * (rstd * post) * gv; v2u w; w.x = pk2(y.x, y.y); w.y = pk2(y.z, y.w);
            ((v2u*)(ATT + (size_t)t * DM + h * 256))[lane] = w; } }
    }
}

typedef const __attribute__((address_space(4))) Args* CArgs;
__device__ __forceinline__ CArgs KA() { CArgs p = (CArgs)__builtin_amdgcn_kernarg_segment_ptr(); asm volatile("" : "+s"(p)); return p; }
#define WSP(off) (KA()->ws + (off))
#define INP(i) (KA()->in[i])
__global__ void __launch_bounds__(NWAVES * 64, 2) fwd_kernel(Args args) {
    extern __shared__ __attribute__((aligned(16))) unsigned char lds[];
    LAS unsigned char* const L = (LAS unsigned char*)lds;
    volatile LAS unsigned* const MISC = (volatile LAS unsigned*)(L + MISC_OFF);
    const int tid = threadIdx.x, wv = __builtin_amdgcn_readfirstlane(tid >> 6);
    const int G = gridDim.x, bx = blockIdx.x;
    const int vcu = (G % 8 == 0) ? (bx % 8) * (G / 8) + bx / 8 : bx;
    for (int u = tid; u < (LDS_BYTES - LDSCTL_OFF) / 4; u += NWAVES * 64) ((LAS unsigned*)(L + LDSCTL_OFF))[u] = 0u;
    __syncthreads();
#if MK_MULTI_LAUNCH
#define GRID_BAR() do { if (tid == 0) __hip_atomic_store((unsigned*)WSP(WS_CTL) + CW_TMO, 0xBADBA0u, __ATOMIC_RELAXED, __HIP_MEMORY_SCOPE_AGENT); } while (0)
#else
    XcdBarrier bar = xcd_barrier_post((unsigned*)WSP(WS_CTL) + CW_BAR, MISC + 8, wv);
#define GRID_BAR() xcd_barrier(bar)
#endif
    const int lo = KA()->ph_lo, hi = KA()->ph_hi; int ph = 0;
#ifndef PHASE_MASK
#define PHASE_MASK 0xFFFFFFFFu
#endif
#define HASP(k) (((PHASE_MASK) >> (k)) & 1u)
#define RUN() (lo <= ph && ph < hi)
#define SEAM() do { if (RUN() && ph + 1 < hi) GRID_BAR(); ++ph; } while (0)
#define GEMM_SITE(EPI, Aoff, Boff, N_, K_, ...) do { pg8::Gemm g{(const bf16*)WSP(Aoff), (const bf16*)WSP(Boff), SEQ, (N_), (K_)}; pg8::StaticOrder S; S.init(SEQ, (N_), G, bx); \
        pg8::EPI E{__VA_ARGS__}; pg8::gemm_phase<pg8::EPI, pg8::StaticOrder, pg8::EPI::ALIGN, true>(L + RING_OFF, g, S, E, wv); } while (0)

    if (HASP(0) && RUN()) prologue_weights(KA(), L, vcu, G, wv);
    SEAM();
    for (int s = 0; s < 2 * DEPTH; ++s) {
        const int l = s >> 1, j = s & 1;
        if (HASP(1) && RUN()) { if (s == 0) norm_phase<false, false>(INP(0), INP(1), WSP(WS_HN), L, vcu, G, wv); else norm_phase<false, true>(WSP(WS_H), INP(1) + (size_t)(l * 2 + j) * DM, WSP(WS_HN), L, vcu, G, wv); }
        SEAM();
        if (HASP(2) && RUN()) GEMM_SITE(EpiSwiGLU, WS_HN, WS_W1 + (size_t)s * W1_SZ, 2 * DFF, DM, (bf16*)WSP(WS_ACT), DFF);
        SEAM();
        if (HASP(3) && RUN()) GEMM_SITE(EpiResidF16, WS_ACT, WS_W2 + (size_t)s * W2_SZ, DM, DFF, s == 0 ? INP(0) : (const float*)nullptr, (_Float16*)WSP(WS_H), DM, 0.5f);
        SEAM();
        if (j == 0) {
            if (HASP(1) && RUN()) norm_phase<false, true>(WSP(WS_H), INP(4) + (size_t)l * DM, WSP(WS_HN), L, vcu, G, wv);
            SEAM();
            if (l < NA) {
                if (HASP(4) && RUN()) { GEMM_SITE(EpiBf16, WS_HN, WS_WAIN + (size_t)l * WAIN_SZ, 3 * DM, DM, (bf16*)WSP(WS_Q), DM, DM, (size_t)SEQ * DM);
                    fgate_phase((const bf16*)WSP(WS_HN), (const bf16*)WSP(WS_WAIN + (size_t)l * WAIN_SZ) + (size_t)3 * DM * DM, INP(6) + l * HA, (float*)WSP(WS_LOGF), vcu, G, wv); }
                SEAM();
                if (HASP(5) && RUN()) { cumsum_phase((const float*)WSP(WS_LOGF), (float*)WSP(WS_ND2), L, vcu, G, wv); norms_phase((const bf16*)WSP(WS_Q), (const bf16*)WSP(WS_K), (float*)WSP(WS_QN), (float*)WSP(WS_KN), (float*)WSP(WS_DG), vcu, G, wv); }
                SEAM();
                if (HASP(6) && RUN()) { att::AttnCfg c{(const bf16*)WSP(WS_Q), (const bf16*)WSP(WS_K), (const bf16*)WSP(WS_V), (void*)WSP(WS_ATT), (const float*)WSP(WS_ND2), (const float*)WSP(WS_QN), (const float*)WSP(WS_KN), (const float*)WSP(WS_DG)};
                    att::attn_phase<0, att::bf16_t, 4096>((char*)lds + RING_OFF, c, G, bx, wv); }
                SEAM();
                if (HASP(7) && RUN()) GEMM_SITE(EpiResidF16, WS_ATT, WS_WAOUT + (size_t)l * WSQ_SZ, DM, DM, (const float*)nullptr, (_Float16*)WSP(WS_H), DM, 1.0f);
                SEAM();
            } else {
                const int jb = l - NA;
                if (HASP(8) && RUN()) GEMM_SITE(EpiBf16, WS_HN, WS_WQB + (size_t)jb * WSQ_SZ, DM, DM, (bf16*)WSP(WS_Q), DM, 0, 0);
                SEAM();
                if (HASP(5) && RUN()) norms_phase((const bf16*)WSP(WS_Q), (const bf16*)WSP(WS_KSH), (float*)WSP(WS_QN), (float*)WSP(WS_KN), (float*)WSP(WS_DG), vcu, G, wv);
                SEAM();
                if (HASP(9) && RUN()) { att::AttnCfg c{(const bf16*)WSP(WS_Q), (const bf16*)WSP(WS_KSH), (const bf16*)WSP(WS_VSH), (void*)WSP(WS_OV), nullptr, (const float*)WSP(WS_QN), (const float*)WSP(WS_KN), (const float*)WSP(WS_DG)};
                    att::attn_phase<1, _Float16, 8192>((char*)lds + RING_OFF, c, G, bx, wv); }
                SEAM();
                if (HASP(10) && RUN()) combine_phase((const _Float16*)WSP(WS_OV), INP(11) + (size_t)jb * 512, INP(12) + (size_t)jb * 256, 0.8f - 0.6f * expf(-0.3f * (float)l), (bf16*)WSP(WS_ATT), vcu, G, wv);
                SEAM();
                if (HASP(11) && RUN()) GEMM_SITE(EpiResidF16, WS_ATT, WS_WOB + (size_t)jb * WSQ_SZ, DM, DM, (const float*)nullptr, (_Float16*)WSP(WS_H), DM, 1.0f);
                SEAM();
            }
        } else if (l == NA - 1) {
            if (HASP(1) && RUN()) norm_phase<false, true>(WSP(WS_H), INP(8), WSP(WS_HN), L, vcu, G, wv);
            SEAM();
            if (HASP(12) && RUN()) GEMM_SITE(EpiBf16, WS_HN, WS_WKV, 2 * DM, DM, (bf16*)WSP(WS_KSH), DM, DM, (size_t)SEQ * DM);
            SEAM();
        }
    }
    if (HASP(13) && RUN()) norm_phase<true, true>(WSP(WS_H), INP(14), KA()->out, L, vcu, G, wv);
    ++ph;
#undef RUN
#undef HASP
#undef SEAM
#undef GRID_BAR
#undef GEMM_SITE
}
constexpr int N_PHASES = 1 + 8 * 3 + 2 * 5 + 2 * 6 + 2 + 1;

extern "C" void kernel_launch(void* const* d_in, const int* in_sizes, int n_in, void* d_out, int out_size, void* d_ws, size_t ws_size, hipStream_t stream) {
    static int grid = 0;
    if (grid == 0) {
        if (n_in != 15 || in_sizes[0] != SEQ * DM || out_size != SEQ * DM || ws_size < WS_END) { fprintf(stderr, "kernel_launch: shape/workspace mismatch (n_in %d, in0 %d, out %d, ws %zu, need %zu); nothing launched\n", n_in, n_in > 0 ? in_sizes[0] : -1, out_size, ws_size, (size_t)WS_END); grid = -1; return; }
        int dev = 0, cus = 0, per_cu = 0;
        if (hipGetDevice(&dev) != hipSuccess || hipDeviceGetAttribute(&cus, hipDeviceAttributeMultiprocessorCount, dev) != hipSuccess) { fprintf(stderr, "kernel_launch: device query failed\n"); grid = -1; return; }
        if (hipFuncSetAttribute((const void*)fwd_kernel, hipFuncAttributeMaxDynamicSharedMemorySize, LDS_BYTES) != hipSuccess) { fprintf(stderr, "kernel_launch: hipFuncSetAttribute failed\n"); grid = -1; return; }
        if (hipOccupancyMaxActiveBlocksPerMultiprocessor(&per_cu, (const void*)fwd_kernel, NWAVES * 64, LDS_BYTES) != hipSuccess || per_cu < 1) { fprintf(stderr, "kernel_launch: occupancy query reports %d workgroups per CU\n", per_cu); }
        (void)hipGetLastError();
        grid = cus;
    }
    if (grid < 0) return;
    if (hipMemsetAsync((char*)d_ws + WS_CTL, 0, CTL_ZERO_BYTES, stream) != hipSuccess) { fprintf(stderr, "kernel_launch: hipMemsetAsync failed\n"); return; }
    Args a{};
    for (int i = 0; i < 15; ++i) a.in[i] = (const float*)d_in[i];
    a.out = (float*)d_out; a.ws = (unsigned char*)d_ws;
#if MK_MULTI_LAUNCH
    for (int p = 0; p < N_PHASES; ++p) { a.ph_lo = p; a.ph_hi = p + 1; hipLaunchKernelGGL(fwd_kernel, dim3(grid), dim3(NWAVES * 64), LDS_BYTES, stream, a); }
#else
    a.ph_lo = 0; a.ph_hi = N_PHASES; hipLaunchKernelGGL(fwd_kernel, dim3(grid), dim3(NWAVES * 64), LDS_BYTES, stream, a);
#endif
#ifdef PROBE_EXTRA
    { static const int extra[] = PROBE_EXTRA; for (unsigned i = 0; i < sizeof(extra) / sizeof(extra[0]); ++i) { a.ph_lo = extra[i]; a.ph_hi = extra[i] + 1; hipLaunchKernelGGL(fwd_kernel, dim3(grid), dim3(NWAVES * 64), LDS_BYTES, stream, a); } }
#endif
    const hipError_t le = hipPeekAtLastError();
    if (le != hipSuccess) fprintf(stderr, "kernel_launch: launch failed: %s\n", hipGetErrorName(le));
}
```

```cpp
#include <hip/hip_runtime.h>
#include <cstdio>
#include <cstdint>

__device__ __forceinline__ int tid_of(int wv) { asm volatile("" : "+s"(wv)); unsigned z = 0u; asm volatile("" : "+v"(z));
    return (wv << 6) | (int)__builtin_amdgcn_mbcnt_hi(~0u, __builtin_amdgcn_mbcnt_lo(~0u, z)); }

#ifndef MK_MULTI_LAUNCH
#define MK_MULTI_LAUNCH 0
#endif

namespace pg8 {
#define PG8_LAS __attribute__((address_space(3)))
typedef unsigned short bf16_t;
typedef short bf16x8 __attribute__((ext_vector_type(8)));
typedef float f32x4 __attribute__((ext_vector_type(4)));
typedef unsigned u32x4 __attribute__((ext_vector_type(4)));
constexpr int BM = 256, BK = 64, HALF = 128, HTB = HALF * BK * 2  , STAGE_BYTES = 8 * HTB, NXCD = 8, WGM = 8;

__host__ __device__ __forceinline__ int lds_byte(int r, int c) { const int st = (r >> 4) * 2 + (c >> 5), rr = r & 15, cc = c & 31, ob = rr * 64 + cc * 2; return st * 1024 + (ob ^ (((ob >> 9) & 1) << 5)); }
__host__ __device__ __forceinline__ void stage_rc(int b, int& R, int& C) { const int st = b / 1024, sb = b % 1024, swz = sb ^ (((sb >> 9) & 1) << 5); R = (st >> 1) * 16 + swz / 64; C = (st & 1) * 32 + (swz % 64) / 2; }
__host__ __device__ __forceinline__ int perm32(int rho) { const int n = rho >> 4, i = rho & 15; return 8 * (i >> 2) + 4 * n + (i & 3); }

struct Unit { int pm, pn; };
struct Gemm { const bf16_t* A; const bf16_t* Bt; int M, N, K; };

struct StaticOrder {
    int nM, nN, nwg, G, c;
    __host__ __device__ void init(int M, int N, int G_, int c_) { nM = M / BM; nN = N / BM; nwg = nM * nN; G = G_; c = c_; }
    __host__ __device__ bool next(int i, Unit& u) const {
        const long L = (long)i * G + c; if (L >= nwg) return false;
        int wgid = (int)L; { const int q = nwg / NXCD, r = nwg % NXCD, xcd = wgid % NXCD, off = wgid / NXCD; wgid = (xcd < r ? xcd * (q + 1) : r * (q + 1) + (xcd - r) * q) + off; }
        const int nig = WGM * nN, gid = wgid / nig, fm = gid * WGM, gsz = (nM - fm) < WGM ? (nM - fm) : WGM;
        u.pm = fm + ((wgid % nig) % gsz); u.pn = (wgid % nig) / gsz; return true;
    }
    __device__ __forceinline__ void a_ready(const Unit&) const {}
    __device__ __forceinline__ void done(const Unit&) const {}
};


__device__ __forceinline__ unsigned cvt_pk_bf16(float lo, float hi) { unsigned r; asm volatile("v_cvt_pk_bf16_f32 %0, %1, %2" : "=v"(r) : "v"(lo), "v"(hi)); return r; }

struct EpiBf16 {   static constexpr bool ALIGN = true;
    static constexpr bool PERM = true, AFTER_DRAIN = false;
    bf16_t* O; int ldc; int split_cols; size_t split_stride;
    __device__ __forceinline__ void operator()(const f32x4 (&acc)[2][2][4][2], const Unit& u, int wr, int wc, int fr, int fq) const {
        const int row0 = u.pm * BM + wr * 64 + fr; int colt = u.pn * BM; bf16_t* base = O;
        if (split_cols) { const int t = colt / split_cols; base += (size_t)t * split_stride; colt -= t * split_cols; }
        const int col0 = colt + wc * 32 + 8 * fq;
#pragma unroll
        for (int ai = 0; ai < 2; ++ai)
#pragma unroll
            for (int m = 0; m < 4; ++m) { bf16_t* rowp = base + (size_t)(row0 + ai * HALF + m * 16) * ldc + col0;
#pragma unroll
                for (int bj = 0; bj < 2; ++bj) { const f32x4 v0 = acc[ai][bj][m][0], v1 = acc[ai][bj][m][1];
                    u32x4 w; w.x = cvt_pk_bf16(v0[0], v0[1]); w.y = cvt_pk_bf16(v0[2], v0[3]); w.z = cvt_pk_bf16(v1[0], v1[1]); w.w = cvt_pk_bf16(v1[2], v1[3]);
                    *(u32x4*)(rowp + bj * HALF) = w; } }
    }
};
__device__ __forceinline__ float silu_mul(float g, float u) { return g * u * __builtin_amdgcn_rcpf(1.0f + __builtin_amdgcn_exp2f(-1.4426950408889634f * g)); }
struct EpiSwiGLU {
    static constexpr bool ALIGN = true;
    static constexpr bool PERM = true, AFTER_DRAIN = false;
    bf16_t* O; int ldc;
    __device__ __forceinline__ void operator()(const f32x4 (&acc)[2][2][4][2], const Unit& u, int wr, int wc, int fr, int fq) const {
        const int row0 = u.pm * BM + wr * 64 + fr, col0 = u.pn * HALF + wc * 32 + 8 * fq;
#pragma unroll
        for (int ai = 0; ai < 2; ++ai)
#pragma unroll
            for (int m = 0; m < 4; ++m) { bf16_t* rowp = O + (size_t)(row0 + ai * HALF + m * 16) * ldc + col0;
                const f32x4 g0 = acc[ai][0][m][0], g1 = acc[ai][0][m][1], u0 = acc[ai][1][m][0], u1 = acc[ai][1][m][1];
                u32x4 w; w.x = cvt_pk_bf16(silu_mul(g0[0], u0[0]), silu_mul(g0[1], u0[1])); w.y = cvt_pk_bf16(silu_mul(g0[2], u0[2]), silu_mul(g0[3], u0[3]));
                w.z = cvt_pk_bf16(silu_mul(g1[0], u1[0]), silu_mul(g1[1], u1[1])); w.w = cvt_pk_bf16(silu_mul(g1[2], u1[2]), silu_mul(g1[3], u1[3]));
                *(u32x4*)rowp = w; }
    }
};
typedef _Float16 h16x8 __attribute__((ext_vector_type(8)));
__device__ __forceinline__ h16x8 to_h16x8(f32x4 a, f32x4 b) { h16x8 r;
#pragma unroll
    for (int j = 0; j < 4; ++j) { r[j] = (_Float16)fminf(fmaxf(a[j], -65504.f), 65504.f); r[4 + j] = (_Float16)fminf(fmaxf(b[j], -65504.f), 65504.f); }
    return r; }
struct EpiResidF16 {
    static constexpr bool ALIGN = true;
    static constexpr bool PERM = true, AFTER_DRAIN = false;
    const float* basef; _Float16* h; int ldc; float alpha;
    __device__ __forceinline__ void operator()(const f32x4 (&acc)[2][2][4][2], const Unit& u, int wr, int wc, int fr, int fq) const {
        const int row0 = u.pm * BM + wr * 64 + fr, col0 = u.pn * BM + wc * 32 + 8 * fq;
        if (basef) {
#pragma unroll
            for (int g = 0; g < 8; ++g) { const int ai = g >> 2, m = g & 3; const size_t off = (size_t)(row0 + ai * HALF + m * 16) * ldc + col0;
#pragma unroll
                for (int bj = 0; bj < 2; ++bj) { const f32x4 b0 = *(const f32x4*)(basef + off + bj * HALF), b1 = *(const f32x4*)(basef + off + bj * HALF + 4);
                    *(h16x8*)(h + off + bj * HALF) = to_h16x8(b0 + acc[ai][bj][m][0] * alpha, b1 + acc[ai][bj][m][1] * alpha); }
                asm volatile("" ::: "memory"); }
        } else {
            h16x8 nb[2];
            { const size_t off = (size_t)row0 * ldc + col0; nb[0] = *(const h16x8*)(h + off); nb[1] = *(const h16x8*)(h + off + HALF); }
#pragma unroll
            for (int g = 0; g < 8; ++g) { const int ai = g >> 2, m = g & 3; const size_t off = (size_t)(row0 + ai * HALF + m * 16) * ldc + col0;
                const h16x8 c0 = nb[0], c1 = nb[1];
                if (g + 1 < 8) { const size_t offn = (size_t)(row0 + ((g + 1) >> 2) * HALF + ((g + 1) & 3) * 16) * ldc + col0; nb[0] = *(const h16x8*)(h + offn); nb[1] = *(const h16x8*)(h + offn + HALF); }
                asm volatile("" ::: "memory");
#pragma unroll
                for (int bj = 0; bj < 2; ++bj) { const h16x8 c = bj ? c1 : c0;
                    const f32x4 b0 = {(float)c[0], (float)c[1], (float)c[2], (float)c[3]}, b1 = {(float)c[4], (float)c[5], (float)c[6], (float)c[7]};
                    *(h16x8*)(h + off + bj * HALF) = to_h16x8(b0 + acc[ai][bj][m][0] * alpha, b1 + acc[ai][bj][m][1] * alpha); }
                asm volatile("" ::: "memory"); }
        }
    }
};

template <class Epi, class Sched, bool ALIGN_EPI = false, bool SP2 = false>
__device__ __forceinline__ void gemm_phase(PG8_LAS unsigned char* lds, const Gemm g, const Sched& S, const Epi& E, int wv) {
    const int tid_ = tid_of(wv);
    const int tid = tid_, wid = __builtin_amdgcn_readfirstlane(tid >> 6), lane = tid & 63, wr = wid >> 2, wc = wid & 3, fr = lane & 15, fq = lane >> 4;
    const int K = g.K, nt = K / BK;
    unsigned voffA[2], voffB[2];
#pragma unroll
    for (int i = 0; i < 2; ++i) { int R, C; stage_rc(tid * 16 + i * 8192, R, C); const int Rb = Epi::PERM ? ((R & ~31) + perm32(R & 31)) : R;
        voffA[i] = (unsigned)(R * K + C) * 2u; voffB[i] = (unsigned)(Rb * K + C) * 2u; }
    const size_t kstep = (size_t)(BK * 2);
    const size_t hstep = (size_t)HALF * K * 2;
    const size_t tstep = 2 * hstep;
    const unsigned ldsw = (unsigned)wid * 1024u;
    const int aoff = lds_byte(wr * 64 + fr, fq * 8), boff = lds_byte(wc * 32 + fr, fq * 8);
#define PG8_SA(b, h) (((b) * 2 + (h)) * HTB)
#define PG8_SB(b, h) ((4 + (b) * 2 + (h)) * HTB)
#define PG8_STAGE(bufoff, gbase, voff) do { _Pragma("unroll") for (int _i = 0; _i < 2; ++_i) \
        __builtin_amdgcn_global_load_lds((const unsigned*)((const char*)(gbase) + (voff)[_i]), (PG8_LAS unsigned*)(lds + (bufoff) + ldsw + _i * 8192), 16, 0, 0); } while (0)
#define PG8_LDA(dst, b, h) do { _Pragma("unroll") for (int m = 0; m < 4; ++m) _Pragma("unroll") for (int k = 0; k < 2; ++k) dst[m][k] = *(const PG8_LAS bf16x8*)(lds + PG8_SA(b, h) + aoff + m * 2048 + k * 1024); } while (0)
#define PG8_LDB(dst, b, h) do { _Pragma("unroll") for (int n = 0; n < 2; ++n) _Pragma("unroll") for (int k = 0; k < 2; ++k) dst[n][k] = *(const PG8_LAS bf16x8*)(lds + PG8_SB(b, h) + boff + n * 2048 + k * 1024); } while (0)
#define PG8_MMA(ai, bj, At, Bt) do { __builtin_amdgcn_s_setprio(1); _Pragma("unroll") for (int m = 0; m < 4; ++m) _Pragma("unroll") for (int n = 0; n < 2; ++n) _Pragma("unroll") for (int k = 0; k < 2; ++k) \
        acc[ai][bj][m][n] = __builtin_amdgcn_mfma_f32_16x16x32_bf16(Bt[n][k], At[m][k], acc[ai][bj][m][n], 0, 0, 0); __builtin_amdgcn_s_setprio(0); } while (0)
#define PG8_WAIT_V(n) asm volatile("s_waitcnt vmcnt(" #n ")" ::: "memory")
#define PG8_WAIT_L(n) asm volatile("s_waitcnt lgkmcnt(" #n ")" ::: "memory")
#define PG8_BAR __builtin_amdgcn_s_barrier()
#define PG8_SCHED __builtin_amdgcn_sched_barrier(0)
    Unit cur, nxt; int ui = 0;
    if (!S.next(0, cur)) return;
    f32x4 acc[2][2][4][2];
#pragma unroll
    for (int a = 0; a < 2; ++a)
#pragma unroll
        for (int b = 0; b < 2; ++b)
#pragma unroll
            for (int m = 0; m < 4; ++m)
#pragma unroll
                for (int n = 0; n < 2; ++n) acc[a][b][m][n] = (f32x4){0.f, 0.f, 0.f, 0.f};
    bf16x8 At[4][2], B0[2][2], B1[2][2];
    const char* cA = (const char*)g.A + (size_t)cur.pm * tstep; const char* cB = (const char*)g.Bt + (size_t)cur.pn * tstep;
    S.a_ready(cur);
    if constexpr (SP2) {
        PG8_STAGE(PG8_SB(0, 0), cB, voffB); PG8_STAGE(PG8_SB(0, 1), cB + hstep, voffB); PG8_STAGE(PG8_SA(0, 0), cA, voffA); PG8_STAGE(PG8_SA(0, 1), cA + hstep, voffA);
        if (wr == 1) PG8_BAR;
        PG8_WAIT_V(2); PG8_BAR;
        PG8_STAGE(PG8_SB(1, 0), cB + kstep, voffB); PG8_STAGE(PG8_SA(1, 0), cA + kstep, voffA); PG8_STAGE(PG8_SB(1, 1), cB + hstep + kstep, voffB);
        PG8_WAIT_V(6); PG8_BAR;
    } else {
        PG8_STAGE(PG8_SB(0, 0), cB, voffB); PG8_STAGE(PG8_SA(0, 0), cA, voffA); PG8_STAGE(PG8_SB(0, 1), cB + hstep, voffB); PG8_STAGE(PG8_SA(0, 1), cA + hstep, voffA);
        if (wr == 1) PG8_BAR;
        PG8_WAIT_V(4); PG8_BAR;
        PG8_STAGE(PG8_SB(1, 0), cB + kstep, voffB); PG8_STAGE(PG8_SA(1, 0), cA + kstep, voffA); PG8_STAGE(PG8_SB(1, 1), cB + hstep + kstep, voffB);
        PG8_WAIT_V(6); PG8_BAR;
    }
    for (;;) {
        const bool has_next = S.next(ui + 1, nxt);
        const char* nA = has_next ? (const char*)g.A + (size_t)nxt.pm * tstep : cA; const char* nB = has_next ? (const char*)g.Bt + (size_t)nxt.pn * tstep : cB;
        for (int t = 0; t < nt; t += 2) {
            const bool last = (t == nt - 2);
            const char* a1 = cA + (size_t)(t + 1) * kstep;
            const char* a2 = last ? nA : cA + (size_t)(t + 2) * kstep; const char* b2 = last ? nB : cB + (size_t)(t + 2) * kstep;
            const char* a3 = a2 + kstep; const char* b3 = b2 + kstep;
            if (last && has_next) S.a_ready(nxt);
            if constexpr (SP2) {
            PG8_LDB(B0, 0, 0); PG8_LDB(B1, 0, 1); PG8_SCHED; PG8_LDA(At, 0, 0); PG8_STAGE(PG8_SA(1, 1), a1 + hstep, voffA);
            PG8_WAIT_V(8); PG8_WAIT_L(0); PG8_BAR; PG8_MMA(0, 0, At, B0); PG8_MMA(0, 1, At, B1); PG8_BAR; PG8_SCHED;
            PG8_LDA(At, 0, 1); PG8_STAGE(PG8_SB(0, 0), b2, voffB); PG8_STAGE(PG8_SB(0, 1), b2 + hstep, voffB); PG8_STAGE(PG8_SA(0, 0), a2, voffA);
            PG8_WAIT_V(8); PG8_WAIT_L(0); PG8_BAR; PG8_MMA(1, 0, At, B0); PG8_MMA(1, 1, At, B1); PG8_BAR; PG8_SCHED;
            PG8_LDB(B0, 1, 0); PG8_LDB(B1, 1, 1); PG8_SCHED; PG8_LDA(At, 1, 0); PG8_STAGE(PG8_SA(0, 1), a2 + hstep, voffA);
            PG8_WAIT_V(8); PG8_WAIT_L(0); PG8_BAR; PG8_MMA(0, 0, At, B0); PG8_MMA(0, 1, At, B1); PG8_BAR; PG8_SCHED;
            PG8_LDA(At, 1, 1); PG8_STAGE(PG8_SB(1, 0), b3, voffB); PG8_STAGE(PG8_SB(1, 1), b3 + hstep, voffB); PG8_STAGE(PG8_SA(1, 0), a3, voffA);
            PG8_WAIT_V(8); PG8_WAIT_L(0); PG8_BAR; PG8_MMA(1, 0, At, B0); PG8_MMA(1, 1, At, B1); PG8_BAR; PG8_SCHED;
            } else {
            PG8_LDB(B0, 0, 0); PG8_SCHED; PG8_LDA(At, 0, 0); PG8_STAGE(PG8_SA(1, 1), a1 + hstep, voffA);
            PG8_WAIT_L(8); PG8_BAR; PG8_WAIT_L(0); PG8_MMA(0, 0, At, B0); PG8_BAR; PG8_SCHED;
            PG8_LDB(B1, 0, 1); PG8_STAGE(PG8_SB(0, 0), b2, voffB);
            PG8_BAR; PG8_WAIT_L(0); PG8_MMA(0, 1, At, B1); PG8_BAR;
            PG8_LDA(At, 0, 1); PG8_STAGE(PG8_SA(0, 0), a2, voffA);
            PG8_BAR; PG8_WAIT_L(0); PG8_MMA(1, 0, At, B0); PG8_BAR; PG8_SCHED;
            PG8_STAGE(PG8_SB(0, 1), b2 + hstep, voffB);
            PG8_WAIT_V(6); PG8_BAR; PG8_MMA(1, 1, At, B1); PG8_BAR;
            PG8_LDB(B0, 1, 0); PG8_SCHED; PG8_LDA(At, 1, 0); PG8_STAGE(PG8_SA(0, 1), a2 + hstep, voffA);
            PG8_WAIT_L(8); PG8_BAR; PG8_WAIT_L(0); PG8_MMA(0, 0, At, B0); PG8_BAR; PG8_SCHED;
            PG8_LDB(B1, 1, 1); PG8_STAGE(PG8_SB(1, 0), b3, voffB);
            PG8_BAR; PG8_WAIT_L(0); PG8_MMA(0, 1, At, B1); PG8_BAR;
            PG8_LDA(At, 1, 1); PG8_STAGE(PG8_SA(1, 0), a3, voffA);
            PG8_BAR; PG8_WAIT_L(0); PG8_MMA(1, 0, At, B0); PG8_BAR; PG8_SCHED;
            PG8_STAGE(PG8_SB(1, 1), b3 + hstep, voffB);
            PG8_WAIT_V(6); PG8_BAR; PG8_MMA(1, 1, At, B1); PG8_BAR;
            }
        }
        if constexpr (ALIGN_EPI) { if (wr == 0) PG8_BAR; }
        if constexpr (!Epi::AFTER_DRAIN) { E(acc, cur, wr, wc, fr, fq); S.done(cur); }
        if (!has_next) break;
#pragma unroll
        for (int a = 0; a < 2; ++a)
#pragma unroll
            for (int b = 0; b < 2; ++b)
#pragma unroll
                for (int m = 0; m < 4; ++m)
#pragma unroll
                    for (int n = 0; n < 2; ++n) acc[a][b][m][n] = (f32x4){0.f, 0.f, 0.f, 0.f};
        cur = nxt; cA = nA; cB = nB; ++ui;
        if constexpr (ALIGN_EPI) { if (wr == 1) PG8_BAR; }
    }
    PG8_WAIT_V(0);
    if constexpr (!ALIGN_EPI) { if (wr == 0) PG8_BAR; }
    PG8_BAR;
    if constexpr (Epi::AFTER_DRAIN) { E.fused(acc, cur, wr, wc, fr, fq, lds, wid, lane); S.done(cur); }
#undef PG8_SA
#undef PG8_SB
#undef PG8_STAGE
#undef PG8_LDA
#undef PG8_LDB
#undef PG8_MMA
#undef PG8_WAIT_V
#undef PG8_WAIT_L
#undef PG8_BAR
#undef PG8_SCHED
}
}

template <int CTRL, int ROW_MASK = 0xf> __device__ __forceinline__ float dppf(float v) {
    return __builtin_bit_cast(float, __builtin_amdgcn_update_dpp(0, __builtin_bit_cast(int, v), CTRL, ROW_MASK, 0xf, false)); }
__device__ __forceinline__ float lanef(float v, int l) { return __builtin_bit_cast(float, __builtin_amdgcn_readlane(__builtin_bit_cast(int, v), l)); }
__device__ __forceinline__ float swap1f(float v) { return dppf<0xB1>(v); }
__device__ __forceinline__ float row16_sum(float v) { v += dppf<0xB1>(v); v += dppf<0x4E>(v); v += dppf<0x141>(v); v += dppf<0x140>(v); return v; }
__device__ __forceinline__ float row16_max(float v) { v = fmaxf(v, dppf<0xB1>(v)); v = fmaxf(v, dppf<0x4E>(v)); v = fmaxf(v, dppf<0x141>(v)); v = fmaxf(v, dppf<0x140>(v)); return v; }
__device__ __forceinline__ float wave_sum(float v) { v = row16_sum(v); return (lanef(v, 0) + lanef(v, 16)) + (lanef(v, 32) + lanef(v, 48)); }
__device__ __forceinline__ float wave_max_pos(float v) { v = row16_max(v); return fmaxf(fmaxf(lanef(v, 0), lanef(v, 16)), fmaxf(lanef(v, 32), lanef(v, 48))); }
__device__ __forceinline__ float wave_incl_scan(float v) {
    v += dppf<0x111>(v); v += dppf<0x112>(v); v += dppf<0x114>(v); v += dppf<0x118>(v);
    v += dppf<0x142, 0xA>(v);
    v += dppf<0x143, 0xC>(v);
    return v; }

namespace att {
typedef unsigned short bf16_t;
typedef short bf16x8 __attribute__((ext_vector_type(8)));
typedef short s16x4 __attribute__((ext_vector_type(4)));
typedef float f32x16 __attribute__((ext_vector_type(16)));
typedef float f32x4 __attribute__((ext_vector_type(4)));
typedef unsigned u32x4 __attribute__((ext_vector_type(4)));
constexpr int D = 128, RS = 4096;
constexpr int NW = 8, QBLK = 32, KVBLK = 64, QB = NW * QBLK;
constexpr int SHM_V = KVBLK * D * 2, SHM_K = KVBLK * D * 2;
constexpr int OFF_WS = 3 * SHM_V + 3 * SHM_K, OFF_KB = OFF_WS + NW * 64 * 4, OFF_JT = OFF_KB + 3 * 64 * 4, LDS_BYTES = OFF_JT + 64;
constexpr float SCALE = 0.08838834764831845f, LOG2E = 1.4426950408889634f, C2 = LOG2E * SCALE, THR2 = 30.f, SKIP_LOG2 = 41.f;

#define KSWZ(row, colB) ((row) * 256 + ((colB) ^ (((row) & 7) << 4)))
#define SBAR() __builtin_amdgcn_sched_barrier(0)
__device__ __forceinline__ int v_st(int k, int c) { const int kk = (k & ~0xC) | ((k & 4) << 1) | ((k & 8) >> 1); return ((kk >> 3) * 4 + (c >> 5)) * 512 + ((kk & 7) * 32 + (c & 31)) * 2; }
__device__ __forceinline__ int v_rd_base(int lane) { return ((lane & 3) << 3) | (((lane >> 2) & 3) << 6) | (((lane >> 4) & 1) << 5) | (((lane >> 5) & 1) << 8); }
constexpr int v_rd_off(int d0, int ks, int half) { return d0 * 512 + ks * 4096 + half * 2048; }
__device__ __forceinline__ int crow(int r, int hi) { return (r & 3) + 8 * (r >> 2) + 4 * hi; }
__device__ __forceinline__ unsigned cvtpk(float lo, float hi) { unsigned r; asm volatile("v_cvt_pk_bf16_f32 %0, %1, %2" : "=v"(r) : "v"(lo), "v"(hi)); return r; }
__device__ __forceinline__ bf16x8 ld8(const bf16_t* p) { return *reinterpret_cast<const bf16x8*>(p); }

__device__ __forceinline__ void mask_tile(f32x16& p0, f32x16& p1, int dq) {
    const float NEG = -__builtin_inff();
#pragma unroll
    for (int r = 0; r < 16; ++r) {
        const int c = (r & 3) + 8 * (r >> 2);
        if (dq - c < 0) p0[r] = NEG;
        if (dq - c - 32 < 0) p1[r] = NEG;
    }
}
__device__ __forceinline__ void mask_all(f32x16& p0, f32x16& p1) {
    const float NEG = -__builtin_inff();
#pragma unroll
    for (int r = 0; r < 16; ++r) { p0[r] = NEG; p1[r] = NEG; }
}
__device__ __forceinline__ void diag_fix(f32x16& p0, f32x16& p1, int dq, float slope2) {
    const float dqf = (float)dq, m2 = -2.f * slope2;
#pragma unroll
    for (int r = 0; r < 16; ++r) {
        const float c = (float)((r & 3) + 8 * (r >> 2));
        p0[r] = fmaf(fmaxf(c - dqf, 0.f), m2, p0[r]);
        p1[r] = fmaf(fmaxf(c + 32.f - dqf, 0.f), m2, p1[r]);
    }
}
__device__ __forceinline__ void add_bias(f32x16& p0, f32x16& p1, const float* kb) {
#pragma unroll
    for (int g = 0; g < 4; ++g) { const f32x4 b0 = *(const f32x4*)(kb + 8 * g), b1 = *(const f32x4*)(kb + 32 + 8 * g);
#pragma unroll
        for (int j = 0; j < 4; ++j) { p0[4 * g + j] = fmaf(p0[4 * g + j], C2, b0[j]); p1[4 * g + j] = fmaf(p1[4 * g + j], C2, b1[j]); } }
}
__device__ __forceinline__ void partialSM(f32x16& p0, f32x16& p1, float& m_reg, float& mn, float& alpha, bool& skp, int& nskip) {
    float pmax = p0[0];
#pragma unroll
    for (int r = 1; r < 16; ++r) pmax = fmaxf(pmax, p0[r]);
#pragma unroll
    for (int r = 0; r < 16; ++r) pmax = fmaxf(pmax, p1[r]);
    { auto rr = __builtin_amdgcn_permlane32_swap(__float_as_uint(pmax), __float_as_uint(pmax), false, false);
      pmax = fmaxf(__uint_as_float(rr[0]), __uint_as_float(rr[1])); }
    { const int L_ = nskip ? 32 - __builtin_clz((unsigned)nskip) : 0; skp = __all(pmax - m_reg < -(34.f + 2.f * (float)L_)); nskip += skp ? 1 : 0; }
    if (__builtin_expect(__all(pmax - m_reg <= THR2), 1)) { mn = m_reg; alpha = 1.f; }
    else { mn = fmaxf(m_reg, pmax); alpha = __builtin_amdgcn_exp2f(m_reg - mn); m_reg = mn; }
    if (skp) return;
#pragma unroll
    for (int r = 0; r < 16; ++r) { p0[r] = p0[r] - mn; p1[r] = p1[r] - mn; }
#pragma unroll
    for (int r = 0; r < 16; ++r) p0[r] = __builtin_amdgcn_exp2f(p0[r]);
}
__device__ __forceinline__ void finishSM(f32x16& p0, f32x16& p1, float alpha, float& l_reg, bf16x8& pa0, bf16x8& pa1, bf16x8& pa2, bf16x8& pa3) {
#pragma unroll
    for (int r = 0; r < 16; ++r) p1[r] = __builtin_amdgcn_exp2f(p1[r]);
    float ps = 0;
#pragma unroll
    for (int r = 0; r < 16; ++r) ps += p0[r];
#pragma unroll
    for (int r = 0; r < 16; ++r) ps += p1[r];
    { auto rr = __builtin_amdgcn_permlane32_swap(__float_as_uint(ps), __float_as_uint(ps), false, false);
      ps = __uint_as_float(rr[0]) + __uint_as_float(rr[1]); }
    l_reg = l_reg * alpha + ps;
#define PK4(P, B_, OUT) do { unsigned a0 = cvtpk(P[B_+0], P[B_+1]), a1 = cvtpk(P[B_+2], P[B_+3]);                          \
        unsigned b0 = cvtpk(P[B_+4], P[B_+5]), b1 = cvtpk(P[B_+6], P[B_+7]);                                             \
        auto r0 = __builtin_amdgcn_permlane32_swap(a0, b0, false, false); auto r1 = __builtin_amdgcn_permlane32_swap(a1, b1, false, false); \
        u32x4 w = {r0[0], r1[0], r0[1], r1[1]}; OUT = *reinterpret_cast<bf16x8*>(&w); } while (0)
    PK4(p0, 0, pa0); PK4(p0, 8, pa1); PK4(p1, 0, pa2); PK4(p1, 8, pa3);
#undef PK4
}
__device__ __forceinline__ void qkt(f32x16& p0, f32x16& p1, const char* K_buf, int r32, int hi, const bf16x8* qr) {
    p0 = f32x16{}; p1 = f32x16{};
    const char* kb[4];
#pragma unroll
    for (int dd = 0; dd < 4; ++dd) kb[dd] = K_buf + KSWZ(r32, (dd * 16 + hi * 8) * 2);
#pragma unroll
    for (int d0 = 0; d0 < 8; ++d0) { const char* a = kb[d0 & 3] + (d0 >> 2) * 128;
        bf16x8 b0 = *reinterpret_cast<const bf16x8*>(a);
        bf16x8 b1 = *reinterpret_cast<const bf16x8*>(a + 32 * 256);
        p0 = __builtin_amdgcn_mfma_f32_32x32x16_bf16(b0, qr[d0], p0, 0, 0, 0);
        p1 = __builtin_amdgcn_mfma_f32_32x32x16_bf16(b1, qr[d0], p1, 0, 0, 0); }
}
template <int VB>
__device__ __forceinline__ void pv_tile(f32x16* o, int vb0, bf16x8 pa0, bf16x8 pa1, bf16x8 pa2, bf16x8 pa3) {
#define TRRD(dst, off) asm volatile("ds_read_b64_tr_b16 %0, %1 offset:%2" : "=&v"(dst) : "v"(vb0), "i"(off) : "memory")
#define PV_D0(d0) do { s16x4 l0, l1, l2, l3, h0, h1, h2, h3; constexpr int b_ = VB * SHM_V + v_rd_off(d0, 0, 0);     \
        TRRD(l0, b_); TRRD(h0, b_ + 2048); TRRD(l1, b_ + 4096); TRRD(h1, b_ + 6144); TRRD(l2, b_ + 8192); TRRD(h2, b_ + 10240); TRRD(l3, b_ + 12288); TRRD(h3, b_ + 14336); \
        asm volatile("s_waitcnt lgkmcnt(0)" ::: "memory"); SBAR();                 \
        o[d0] = __builtin_amdgcn_mfma_f32_32x32x16_bf16(pa0, (bf16x8){l0[0], l0[1], l0[2], l0[3], h0[0], h0[1], h0[2], h0[3]}, o[d0], 0, 0, 0);   \
        o[d0] = __builtin_amdgcn_mfma_f32_32x32x16_bf16(pa1, (bf16x8){l1[0], l1[1], l1[2], l1[3], h1[0], h1[1], h1[2], h1[3]}, o[d0], 0, 0, 0);   \
        o[d0] = __builtin_amdgcn_mfma_f32_32x32x16_bf16(pa2, (bf16x8){l2[0], l2[1], l2[2], l2[3], h2[0], h2[1], h2[2], h2[3]}, o[d0], 0, 0, 0);   \
        o[d0] = __builtin_amdgcn_mfma_f32_32x32x16_bf16(pa3, (bf16x8){l3[0], l3[1], l3[2], l3[3], h3[0], h3[1], h3[2], h3[3]}, o[d0], 0, 0, 0); } while (0)
    PV_D0(0); PV_D0(1); PV_D0(2); PV_D0(3);
#undef PV_D0
#undef TRRD
}

template <class T> struct IS_F16 { static constexpr bool v = false; };
template <> struct IS_F16<_Float16> { static constexpr bool v = true; };
template <class TOut> struct BlockRef { const bf16_t* Q; const bf16_t* K; const bf16_t* V; TOut* O; const float* KBs; float slope2; int P0, jlo; };
struct Seam { bf16x8 qr[8]; };
typedef __attribute__((address_space(3))) unsigned las_u32;
#define VMW() asm volatile("s_waitcnt vmcnt(0)" ::: "memory")
#define VMWN(n) asm volatile("s_waitcnt vmcnt(%0)" :: "i"(n) : "memory")
#define ABAR() do { asm volatile("s_waitcnt lgkmcnt(0)" ::: "memory"); __builtin_amdgcn_s_barrier(); asm volatile("" ::: "memory"); } while (0)
#define LDSP(off) ((las_u32*)(uintptr_t)(lbase + (unsigned)(off)))
#define DMA_K_(Kp, KBp, sl2, P0v, k0, bf) do { const char* g_ = (const char*)(Kp) + (size_t)(k0) * (RS * 2) + koff; const unsigned lo_ = 3 * SHM_V + (unsigned)(bf) * SHM_K + wid * 1024; \
        __builtin_amdgcn_global_load_lds((const unsigned*)g_, LDSP(lo_), 16, 0, 0);                                                                              \
        __builtin_amdgcn_global_load_lds((const unsigned*)(g_ + 32 * RS * 2), LDSP(lo_ + 8192), 16, 0, 0);                                                       \
          \
                             \
        if (MODE == 0) __builtin_amdgcn_global_load_lds((const unsigned*)((KBp) + (k0) + lane), LDSP(OFF_KB + (unsigned)(bf) * 256), 4, 0, 0);                        \
        else { int d_ = (k0) - (P0v); asm volatile("" : "+s"(d_)); if (tid < 64) kb_l[(bf) * 64 + tid] = (sl2) * (float)(d_ + lane); } } while (0)
#define DMA_K(R, k0, bf) DMA_K_((R).K, (R).KBs, (R).slope2, (R).P0, k0, bf)
#define DMA_V(R, k0, bf) do { const char* g_ = (const char*)(R).V + (size_t)(k0) * (RS * 2) + voff; const unsigned lv_ = (unsigned)(bf) * SHM_V + wid * 2048;            \
        __builtin_amdgcn_global_load_lds((const unsigned*)g_, LDSP(lv_), 16, 0, 0);                                                                               \
        __builtin_amdgcn_global_load_lds((const unsigned*)(g_ + 128), LDSP(lv_ + 1024), 16, 0, 0); } while (0)
#define DMA_OFFS() const unsigned lbase = (unsigned)(uintptr_t)lds;                                                                                              \
        const int krow_ = 4 * wid + (lane >> 4), kk_ = 8 * wid + ((lane & 31) >> 2), vk_ = (kk_ & ~0xC) | ((kk_ & 4) << 1) | ((kk_ & 8) >> 1);                  \
        const unsigned koff = (unsigned)(krow_ * RS + (((lane & 15) ^ (krow_ & 7)) * 8)) * 2u, voff = (unsigned)(vk_ * RS + (lane >> 5) * 32 + (lane & 3) * 8) * 2u
constexpr int NBL(int mode) { return mode == 0 ? 1 : 0; }
template <int MODE, class TOut>
__device__ __forceinline__ void attn_prime(const BlockRef<TOut>& cur, char* lds, Seam& S, const int tid) {
    const int wid = __builtin_amdgcn_readfirstlane(tid >> 6), lane = tid & 63, r32 = lane & 31, hi = lane >> 5;
    float* kb_l = (float*)(lds + OFF_KB);
    DMA_OFFS();
#pragma unroll
    for (int d0 = 0; d0 < 8; ++d0) S.qr[d0] = ld8(cur.Q + (size_t)(wid * QBLK + r32) * RS + d0 * 16 + hi * 8);
    DMA_K(cur, cur.P0 + 3 * KVBLK, 0); DMA_V(cur, cur.P0 + 3 * KVBLK, 0);
    DMA_K(cur, cur.P0 + 2 * KVBLK, 1);
    VMW();
    ABAR();
}
template <int MODE, class TOut, int OS>
__device__ __forceinline__ void attn_block(const BlockRef<TOut>& cur, const BlockRef<TOut>& nxt, char* lds, Seam& S, const int tid, int& kph) {
    const int wid = __builtin_amdgcn_readfirstlane(tid >> 6), lane = tid & 63, r32 = lane & 31, hi = lane >> 5;
    const int NT = cur.P0 / KVBLK + 4 - cur.jlo;
    const int qlo = cur.P0 + wid * QBLK, qm = qlo + r32 - 4 * hi;
    char* V_lds = lds; char* K_lds = lds + 3 * SHM_V; float* kb_l = (float*)(lds + OFF_KB);
    float* ws = (float*)(lds + OFF_WS) + wid * 64; float* li_l = ws, * al_l = ws + 32;
    float m_reg = -1e30f, l_reg = 0; f32x16 o[4] = {}; int nskip = 0;
    DMA_OFFS();
    const int vb0 = (int)(uintptr_t)V_lds + v_rd_base(lane);
#define RESC(a) do { if (__any((a) < 1.f)) { if (hi == 0) al_l[r32] = (a); asm volatile("s_waitcnt lgkmcnt(0)" ::: "memory");              \
                     for (int d_ = 0; d_ < 4; ++d_) for (int r = 0; r < 16; ++r) o[d_][r] *= al_l[crow(r, hi)]; } } while (0)
#define KBASE(t) (cur.P0 + (3 - (t)) * KVBLK)
#define BIASMASK(P0_, P1_, t, KB) do { add_bias(P0_, P1_, kb_l + (KB) * 64 + 4 * hi); const int kb_ = KBASE(t);                               \
        if (MODE == 0) { if (kb_ + KVBLK - 1 > qlo) mask_tile(P0_, P1_, qm - kb_); }                                                         \
        else { const int ct_ = qlo >> 6, tj_ = kb_ >> 6; if (tj_ > ct_) mask_all(P0_, P1_); else if (tj_ == ct_) diag_fix(P0_, P1_, qm - kb_, cur.slope2); } } while (0)
    constexpr int NQL = 8, NB = NBL(MODE);
    f32x16 pA0, pA1, pB0, pB1; float mnA, mnB, alA, alB; bf16x8 pa0, pa1, pa2, pa3; bool skA, skB;
    int k0_ = kph, k1_ = kph + 1 == 3 ? 0 : kph + 1, k2_ = k1_ + 1 == 3 ? 0 : k1_ + 1;
#define KROT() do { const int t_ = k0_; k0_ = k1_; k1_ = k2_; k2_ = t_; } while (0)
#define KBUF(b) (K_lds + (b) * SHM_K)
#define VBUF(b) (vb0 + (b) * SHM_V)
    SBAR(); qkt(pA0, pA1, KBUF(k0_), r32, hi, S.qr); SBAR();
    DMA_K(cur, KBASE(2), k2_); DMA_V(cur, KBASE(1), k1_); SBAR();
    BIASMASK(pA0, pA1, 0, k0_); partialSM(pA0, pA1, m_reg, mnA, alA, skA, nskip);
    VMWN(4 + NB);
    ABAR(); KROT();
#define HALF_STEP(PX0, PX1, mnX, alX, skX, PY0, PY1, alY, skY, t) do {                                                                  \
        SBAR(); { const bool nx_ = (t) + 2 >= NT; DMA_K_(nx_ ? nxt.K : cur.K, nx_ ? nxt.KBs : cur.KBs, nx_ ? nxt.slope2 : cur.slope2, nx_ ? nxt.P0 : cur.P0,             \
                                                       nx_ ? nxt.P0 + 3 * KVBLK : KBASE((t) + 2), k2_); } DMA_V(cur, KBASE((t) + 1), k1_); SBAR();  \
        qkt(PX0, PX1, KBUF(k0_), r32, hi, S.qr);                                                                              \
        if (!(skY)) finishSM(PY0, PY1, alY, l_reg, pa0, pa1, pa2, pa3); SBAR();                                               \
        if (!(skY)) pv_tile<0>(o, VBUF(k2_), pa0, pa1, pa2, pa3); BIASMASK(PX0, PX1, (t), k0_); partialSM(PX0, PX1, m_reg, mnX, alX, skX, nskip); \
        VMWN(4 + NB); RESC(alX); ABAR(); KROT(); } while (0)
    for (int t = 1; t + 1 < NT; t += 2) {
        HALF_STEP(pB0, pB1, mnB, alB, skB, pA0, pA1, alA, skA, t);
        HALF_STEP(pA0, pA1, mnA, alA, skA, pB0, pB1, alB, skB, t + 1);
    }
    SBAR(); qkt(pB0, pB1, KBUF(k0_), r32, hi, S.qr); SBAR();
    DMA_K(nxt, nxt.P0 + 2 * KVBLK, k2_); DMA_V(nxt, nxt.P0 + 3 * KVBLK, k1_); SBAR();
#pragma unroll
    for (int d0 = 0; d0 < 8; ++d0) S.qr[d0] = ld8(nxt.Q + (size_t)(wid * QBLK + r32) * RS + d0 * 16 + hi * 8);
    SBAR();
    if (!skA) finishSM(pA0, pA1, alA, l_reg, pa0, pa1, pa2, pa3); SBAR();
    if (!skA) pv_tile<0>(o, VBUF(k2_), pa0, pa1, pa2, pa3);
    BIASMASK(pB0, pB1, NT - 1, k0_); partialSM(pB0, pB1, m_reg, mnB, alB, skB, nskip);
    VMWN(4 + NB + NQL);
    ABAR(); RESC(alB);
    if (!skB) { finishSM(pB0, pB1, alB, l_reg, pa0, pa1, pa2, pa3); SBAR(); pv_tile<0>(o, VBUF(k0_), pa0, pa1, pa2, pa3); }
    SBAR(); kph = k1_;
    if (hi == 0) li_l[r32] = l_reg; asm volatile("s_waitcnt lgkmcnt(0)" ::: "memory");
    float rli[16];
#pragma unroll
    for (int r = 0; r < 16; ++r) rli[r] = __builtin_amdgcn_rcpf(li_l[crow(r, hi)]);
    TOut* Ow = cur.O + (size_t)(wid * QBLK) * OS;
#pragma unroll
    for (int r = 0; r < 16; ++r) { const int orow = crow(r, hi);
#pragma unroll
        for (int d0 = 0; d0 < 4; ++d0) { const float v = o[d0][r] * rli[r];
            if constexpr (sizeof(TOut) == 4) { Ow[(size_t)orow * OS + d0 * 32 + r32] = v; }
            else { const float vn = swap1f(v);
                   if ((r32 & 1) == 0) { unsigned pk_;
                       if constexpr (IS_F16<TOut>::v) { typedef _Float16 h2_ __attribute__((ext_vector_type(2))); const h2_ hh = {(_Float16)v, (_Float16)vn}; pk_ = __builtin_bit_cast(unsigned, hh); }
                       else pk_ = cvtpk(v, vn);
                       *(unsigned*)(Ow + (size_t)orow * OS + d0 * 32 + r32) = pk_; } } } }
    ABAR();
#undef RESC
#undef KBASE
#undef BIASMASK
#undef HALF_STEP
#undef KROT
#undef KBUF
#undef VBUF
}
#undef VMW
#undef VMWN
#undef LDSP
#undef ABAR
#undef DMA_K
#undef DMA_K_
#undef DMA_V
#undef DMA_OFFS

struct AttnCfg { const bf16_t* Q; const bf16_t* K; const bf16_t* V; void* O; const float* KBs; const float* QN; const float* KN; const float* DG; };
__device__ const unsigned short DIFF_TAB[1024] = {1001, 904, 864, 796, 728, 608, 557, 529, 499, 347, 327, 275, 212, 158, 109, 44, 1002, 968, 865, 797, 729, 609, 558, 530, 500, 348, 328, 276, 213, 159, 110, 45, 1003, 866, 798, 730, 713, 704, 605, 553, 525, 491, 442, 300, 264, 237, 188, 75, 1004, 867, 799, 731, 712, 622, 589, 489, 457, 437, 291, 259, 228, 177, 63, 0, 1005, 901, 868, 800, 732, 711, 708, 515, 411, 393, 368, 318, 164, 141, 115, 50, 1006, 965, 869, 801, 775, 772, 733, 475, 451, 416, 373, 246, 196, 87, 22, 5, 1007, 870, 839, 802, 734, 612, 582, 568, 407, 389, 364, 314, 155, 136, 106, 41, 1008, 903, 871, 803, 735, 613, 583, 569, 408, 390, 365, 315, 156, 137, 107, 42, 1009, 967, 872, 804, 736, 614, 584, 570, 409, 391, 366, 316, 157, 138, 108, 43, 1010, 873, 805, 737, 710, 687, 637, 511, 472, 361, 341, 290, 227, 176, 127, 62, 1011, 874, 806, 774, 738, 688, 638, 514, 473, 422, 380, 203, 144, 130, 82, 17, 1012, 875, 838, 807, 739, 689, 639, 578, 474, 423, 381, 204, 145, 131, 83, 18, 1013, 902, 876, 808, 740, 705, 690, 581, 485, 455, 431, 306, 243, 84, 19, 2, 1014, 966, 963, 877, 809, 741, 691, 644, 404, 350, 330, 278, 215, 161, 112, 47, 1015, 878, 810, 742, 678, 648, 628, 502, 463, 352, 332, 281, 218, 167, 118, 53, 1016, 879, 811, 743, 679, 649, 629, 503, 464, 353, 333, 282, 219, 168, 119, 54, 1017, 880, 812, 744, 680, 650, 630, 504, 465, 354, 334, 283, 220, 169, 120, 55, 1018, 881, 813, 745, 681, 651, 631, 505, 466, 355, 335, 284, 221, 170, 121, 56, 1019, 882, 814, 746, 682, 652, 632, 506, 467, 356, 336, 285, 222, 171, 122, 57, 1020, 883, 815, 747, 683, 653, 633, 507, 468, 357, 337, 286, 223, 172, 123, 58, 1021, 884, 816, 748, 684, 654, 634, 508, 469, 358, 338, 287, 224, 173, 124, 59, 1022, 885, 817, 749, 685, 655, 635, 509, 470, 359, 339, 288, 225, 174, 125, 60, 1023, 886, 818, 750, 686, 656, 636, 510, 471, 360, 340, 289, 226, 175, 126, 61, 1000, 863, 795, 767, 727, 706, 610, 560, 532, 438, 292, 260, 229, 178, 65, 64, 999, 862, 794, 758, 722, 596, 580, 579, 412, 394, 369, 319, 179, 142, 128, 66, 998, 861, 841, 793, 760, 598, 545, 517, 480, 426, 385, 293, 230, 192, 180, 67, 997, 860, 842, 833, 792, 776, 603, 550, 522, 486, 433, 309, 252, 95, 30, 11, 996, 859, 791, 782, 676, 643, 616, 586, 424, 398, 382, 205, 146, 132, 88, 23, 995, 858, 830, 790, 675, 615, 585, 571, 410, 392, 367, 317, 162, 139, 113, 48, 994, 857, 828, 789, 703, 668, 575, 543, 425, 399, 383, 206, 147, 133, 89, 24, 993, 961, 856, 845, 831, 707, 677, 617, 587, 435, 400, 311, 255, 100, 35, 14, 992, 960, 910, 906, 855, 840, 606, 554, 526, 492, 446, 304, 268, 241, 193, 79, 991, 975, 854, 754, 718, 625, 592, 496, 460, 343, 323, 271, 208, 149, 98, 33, 990, 853, 848, 777, 759, 597, 576, 544, 516, 479, 420, 378, 257, 201, 186, 73, 989, 977, 850, 764, 726, 641, 602, 549, 521, 484, 430, 305, 242, 81, 16, 1, 988, 913, 895, 763, 725, 640, 601, 577, 548, 520, 483, 429, 299, 236, 187, 74, 987, 978, 852, 755, 719, 626, 593, 497, 461, 344, 324, 272, 209, 150, 101, 36, 986, 914, 899, 890, 780, 773, 673, 620, 403, 349, 329, 277, 214, 160, 111, 46, 985, 979, 891, 779, 693, 658, 556, 528, 498, 346, 326, 274, 211, 154, 105, 40, 984, 915, 887, 835, 829, 709, 672, 619, 402, 345, 325, 273, 210, 153, 104, 39, 949, 925, 909, 837, 781, 674, 627, 501, 462, 351, 331, 279, 216, 165, 116, 51, 973, 950, 926, 843, 769, 669, 647, 642, 559, 531, 432, 308, 250, 93, 28, 9, 951, 927, 844, 825, 700, 665, 572, 540, 413, 395, 370, 321, 163, 140, 114, 49, 952, 928, 908, 826, 701, 666, 573, 541, 414, 396, 371, 244, 194, 85, 20, 3, 972, 953, 929, 827, 702, 667, 574, 542, 415, 397, 372, 245, 195, 86, 21, 4, 954, 930, 834, 819, 783, 768, 694, 659, 562, 534, 443, 301, 265, 238, 189, 76, 955, 931, 898, 832, 820, 784, 695, 660, 563, 535, 444, 302, 266, 239, 190, 77, 962, 956, 932, 896, 821, 785, 696, 661, 564, 536, 445, 303, 267, 240, 191, 78, 957, 933, 822, 786, 697, 662, 565, 537, 450, 421, 379, 202, 143, 129, 80, 15, 958, 934, 823, 787, 698, 663, 566, 538, 405, 387, 362, 312, 151, 134, 102, 37, 959, 935, 824, 788, 699, 664, 567, 539, 406, 388, 363, 313, 152, 135, 103, 38, 974, 970, 936, 924, 692, 657, 552, 524, 490, 439, 320, 295, 261, 232, 182, 69, 937, 923, 846, 778, 770, 714, 611, 561, 533, 440, 384, 296, 262, 233, 183, 70, 983, 938, 847, 751, 715, 621, 588, 488, 456, 436, 280, 258, 217, 166, 117, 52, 969, 939, 922, 911, 766, 607, 555, 527, 495, 342, 322, 270, 207, 148, 96, 31, 940, 921, 849, 752, 716, 623, 590, 493, 458, 447, 307, 269, 248, 91, 26, 7, 982, 976, 941, 762, 724, 600, 547, 519, 513, 512, 482, 428, 298, 235, 185, 72, 942, 920, 912, 900, 757, 721, 595, 477, 453, 418, 376, 251, 199, 94, 29, 10, 943, 919, 851, 753, 717, 624, 591, 494, 459, 386, 374, 247, 197, 90, 25, 6, 944, 918, 894, 761, 723, 599, 546, 518, 481, 449, 427, 294, 256, 231, 181, 68, 981, 945, 893, 836, 756, 720, 594, 476, 452, 417, 375, 249, 198, 92, 27, 8, 946, 917, 905, 897, 892, 765, 604, 551, 523, 487, 434, 310, 253, 97, 32, 12, 964, 947, 916, 907, 888, 670, 646, 478, 454, 419, 377, 254, 200, 99, 34, 13, 980, 971, 948, 889, 771, 671, 645, 618, 448, 441, 401, 297, 263, 234, 184, 71};
template <int MODE> __device__ __forceinline__ bool attn_item(int i, int G, int bx, int& vh, int& qb) {
    constexpr int NVH = MODE == 0 ? 32 : 64;
    if (G == 256) {
        if (MODE == 0) { if (i >= 8) return false; vh = (bx & 7) * 4 + (i >> 1); qb = (i & 1) ? 63 - (bx >> 3) : (bx >> 3); return true; }
        if (i >= 16) return false;
        const unsigned e = DIFF_TAB[(bx >> 2) * 16 + i];
        vh = (int)(e >> 6) * 4 + (bx & 3); qb = (int)(e & 63u); return true;
    }
    const long L = (long)i * G + bx; if (L >= (long)NVH * 64) return false; vh = (int)(L >> 6); qb = (int)(L & 63); return true;
}
template <int MODE> __device__ __forceinline__ int attn_jlo(const AttnCfg& c, int hm, int qb, const float* nd2, float slope2, int lane) {
    const float kn = wave_max_pos(lane <= qb ? c.KN[lane * 32 + hm] : 0.f), qn = c.QN[qb * 32 + hm];
    const float skip = 28.f + __builtin_amdgcn_logf(1.0f / (1.0f - __builtin_amdgcn_exp2f(-(MODE == 0 ? 1.0f : slope2))));
    const float B = C2 * sqrtf(qn * kn) * 1.0001f, Lb = C2 * c.DG[qb * 32 + hm], thr = B - Lb + skip;
    const int jd = qb * 4;
    int jlo;
    if (MODE == 0) {
        const float ref0 = nd2[qb * QB], tau = __builtin_amdgcn_exp2f(-(27.f + 6.f + 0.5f) - (B - Lb)); float carry = 0.f; jlo = 0;
#pragma unroll
        for (int cc = 0; cc < 4; ++cc) { const int jj = lane + 64 * cc; const float x = (jj < jd) ? __builtin_amdgcn_exp2f(nd2[jj * KVBLK + KVBLK - 1] - ref0) : 0.f;
            const float incl = wave_incl_scan(x) + carry, excl = incl - x; carry = lanef(incl, 63);
            const unsigned long long bal = __ballot(jj <= jd && excl < tau); if (bal) { const int f = 63 - __builtin_clzll(bal) + 64 * cc; jlo = f > jlo ? f : jlo; } }
    } else {
        const float w = thr / slope2; const float jf = floorf(((float)(qb * QB - (KVBLK - 1)) - w) * (1.f / KVBLK)) - 1.f;
        jlo = jf < 0.f ? 0 : (jf > (float)jd ? jd : (int)jf);
    }
    jlo = __builtin_amdgcn_readfirstlane(jlo) & ~1;
    return jlo < jd ? jlo : jd;
}
template <int MODE> __device__ __forceinline__ int attn_jlo_vh(const AttnCfg& c, int vh, int qb, int lane) {
    if (MODE == 0) return attn_jlo<0>(c, vh, qb, c.KBs + (size_t)vh * 16384, 0.f, lane);
    return attn_jlo<1>(c, vh >> 1, qb, nullptr, __builtin_amdgcn_exp2f(-0.5f * (float)((vh >> 2) + 1)) * LOG2E, lane);
}
template <int MODE, class TOut> __device__ __forceinline__ BlockRef<TOut> attn_ref(const AttnCfg& c, int vh, int qb, int lane, int jlo_known) {
    BlockRef<TOut> r; const size_t row0 = (size_t)qb * QB; r.P0 = qb * QB;
    if (MODE == 0) {
        r.Q = c.Q + row0 * RS + vh * D; r.K = c.K + vh * D; r.V = c.V + vh * D; r.O = (TOut*)c.O + row0 * 4096 + vh * D; r.KBs = c.KBs + (size_t)vh * 16384; r.slope2 = 0.f;
        r.jlo = jlo_known;
    } else {
        const int h = vh >> 2, mp = (vh >> 1) & 1, vhf = vh & 1;
        r.Q = c.Q + row0 * RS + h * 256 + mp * D; r.K = c.K + h * 256 + mp * D; r.V = c.V + h * 256 + vhf * D; r.O = (TOut*)c.O + row0 * 8192 + vh * D; r.KBs = nullptr;
        r.slope2 = __builtin_amdgcn_exp2f(-0.5f * (float)(h + 1)) * LOG2E;
        r.jlo = jlo_known;
    }
    return r;
}
template <int MODE, class TOut, int OS>
__device__ __forceinline__ void attn_phase(char* lds, const AttnCfg& cfg, int G, int bx_, int wv) {
    int bx = bx_; asm volatile("" : "+s"(bx));
    int i = 0, vh, qb;
    if (!attn_item<MODE>(0, G, bx, vh, qb)) return;
    int* jt = (int*)(lds + OFF_JT);
    { const int tidp = tid_of(wv), lanep = tidp & 63, wid = __builtin_amdgcn_readfirstlane(tidp >> 6);
#pragma unroll
      for (int k = 0; k < 2; ++k) { const int it = wid * 2 + k; int vh_, qb_; if (attn_item<MODE>(it, G, bx, vh_, qb_)) { const int j_ = attn_jlo_vh<MODE>(cfg, vh_, qb_, lanep); if (lanep == 0) jt[it] = j_; } }
      __syncthreads(); }
    const int tid = tid_of(wv);
    const int lane = tid & 63;
    BlockRef<TOut> cur = attn_ref<MODE, TOut>(cfg, vh, qb, lane, __builtin_amdgcn_readfirstlane(jt[0]));
    Seam S;
    if (__builtin_amdgcn_readfirstlane(tid >> 6) >= 4) __builtin_amdgcn_s_setprio(1);
    attn_prime<MODE, TOut>(cur, lds, S, tid); int kph = 0;
    for (;;) {
        int vhn, qbn; const bool last = !attn_item<MODE>(i + 1, G, bx, vhn, qbn);
        const BlockRef<TOut> nxt = last ? cur : attn_ref<MODE, TOut>(cfg, vhn, qbn, lane, (i + 1 < 16) ? __builtin_amdgcn_readfirstlane(jt[(i + 1) & 15]) : 0);
        attn_block<MODE, TOut, OS>(cur, nxt, lds, S, tid, kph);
        if (last) break;
        cur = nxt; ++i;
    }
    __builtin_amdgcn_s_setprio(0);
}
}

constexpr int NWAVES = 8;
constexpr int SEQ = 16384, DM = 4096, DFF = 6144, DEPTH = 4, NA = 2, NB = 2;
constexpr int HA = 32, HB = 16, NQKVA = 3 * DM + HA;
constexpr float EPS = 1e-6f, LOG2E_F = 1.4426950408889634f;
constexpr size_t MiB = (size_t)1 << 20;
constexpr size_t WS_CTL = 0, CTL_ZERO_BYTES = 1 * MiB;
constexpr size_t WS_LOGF = 2 * MiB;
constexpr size_t WS_ND2 = 4 * MiB;
constexpr size_t WS_QN = 6 * MiB, WS_KN = 6 * MiB + 65536, WS_DG = 6 * MiB + 131072;
constexpr size_t WS_W1 = 8 * MiB, W1_SZ = 96 * MiB;
constexpr size_t WS_W2 = WS_W1 + 8 * W1_SZ, W2_SZ = 48 * MiB;
constexpr size_t WS_WAIN = WS_W2 + 8 * W2_SZ, WAIN_SZ = 97 * MiB;
constexpr size_t WS_WAOUT = WS_WAIN + 2 * WAIN_SZ, WSQ_SZ = 32 * MiB;
constexpr size_t WS_WKV = WS_WAOUT + 2 * WSQ_SZ;
constexpr size_t WS_WQB = WS_WKV + 64 * MiB;
constexpr size_t WS_WOB = WS_WQB + 2 * WSQ_SZ;
constexpr size_t WS_H = WS_WOB + 2 * WSQ_SZ;
constexpr size_t WS_HN = WS_H + 256 * MiB;
constexpr size_t WS_ACT = WS_HN + 128 * MiB;
constexpr size_t WS_Q = WS_ACT + 192 * MiB, WS_K = WS_Q + 128 * MiB, WS_V = WS_K + 128 * MiB;
constexpr size_t WS_ATT = WS_V + 128 * MiB;
constexpr size_t WS_KSH = WS_ATT + 128 * MiB, WS_VSH = WS_KSH + 128 * MiB;
constexpr size_t WS_OV = WS_VSH + 128 * MiB;
constexpr size_t WS_END = WS_OV + 512 * MiB;
constexpr int CW_TMO = 0;
constexpr int CW_BAR = 4096;
constexpr int RING_OFF = 0, RING_BYTES = 131072;
constexpr int LDSCTL_OFF = RING_BYTES, MISC_OFF = LDSCTL_OFF + 320;
constexpr int LDS_BYTES = 147456;
static_assert(MISC_OFF + 128 <= LDS_BYTES && att::LDS_BYTES <= RING_BYTES && pg8::STAGE_BYTES <= RING_BYTES, "LDS map");

#define GAS __attribute__((address_space(1)))
#define LAS __attribute__((address_space(3)))
typedef unsigned short bf16;
typedef unsigned v4u __attribute__((ext_vector_type(4)));
typedef unsigned v2u __attribute__((ext_vector_type(2)));
typedef float f32x4 __attribute__((ext_vector_type(4)));
typedef short bf16x8 __attribute__((ext_vector_type(8)));
#define LDS_WAIT() asm volatile("s_waitcnt lgkmcnt(0)" ::: "memory")
__device__ __forceinline__ unsigned f2bf(float f) { unsigned u = __builtin_bit_cast(unsigned, f); return (u + 0x7fffu + ((u >> 16) & 1u)) >> 16; }
__device__ __forceinline__ unsigned pk2(float lo, float hi) { return f2bf(lo) | (f2bf(hi) << 16); }

#define XB_TMO      128
#define XB_XCNT(j)  (256  + 64 * (j))
#define XB_XSUB(j)  (1280 + 64 * (j))
#define XB_XGEN(j)  (2304 + 64 * (j))
#define XB_TOP      3328
#define XB_TOPGEN   3392
#define XCD_BAR_WORDS 3456
#define XB_SPIN_CAP (1u << 22)

__device__ __forceinline__ unsigned xb_ld(unsigned* p)              { return __hip_atomic_load(p, __ATOMIC_RELAXED, __HIP_MEMORY_SCOPE_AGENT); }
__device__ __forceinline__ unsigned xb_add(unsigned* p, unsigned v) { return __hip_atomic_fetch_add(p, v, __ATOMIC_RELAXED, __HIP_MEMORY_SCOPE_AGENT); }
__device__ __forceinline__ unsigned xb_xcc_id() { return (unsigned)__builtin_amdgcn_s_getreg((3 << 11) | 20) & 0xFu; }
#define XB_SPIN(cond, bar) do { unsigned _sp = 0; while (cond) { __builtin_amdgcn_s_sleep(1); \
    if ((++_sp & 255u) == 0u) { if (xb_ld(&(bar)[XB_TMO])) break; if (_sp > XB_SPIN_CAP) { atomicAdd(&(bar)[XB_TMO], 1u); break; } } } } while (0)

struct XcdBarrier {
    unsigned* bar; unsigned x; int wv;
    volatile LAS unsigned* st;
};
__device__ __forceinline__ XcdBarrier xcd_barrier_post(unsigned* bar, volatile LAS unsigned* st, int wv) {
    XcdBarrier b; b.bar = bar; b.x = xb_xcc_id(); b.st = st; b.wv = wv;
    if (threadIdx.x == 0) (void)xb_add(&bar[XB_XCNT(b.x)], 1u);
    return b;
}
__device__ __forceinline__ void xcd_barrier_complete(unsigned* bar, unsigned x, unsigned& nloc, unsigned& nx) {
    const unsigned G = gridDim.x * gridDim.y * gridDim.z;
    unsigned sum, cnt, mine, sp = 0u;
    for (;;) {
        sum = 0u; cnt = 0u; mine = 0u;
#pragma unroll
        for (unsigned j = 0; j < 16; ++j) { const unsigned c = xb_ld(&bar[XB_XCNT(j)]); sum += c; cnt += (c > 0u) ? 1u : 0u; mine = (j == x) ? c : mine; }
        if (sum == G) break;
        __builtin_amdgcn_s_sleep(1);
        if ((++sp & 255u) == 0u) { if (xb_ld(&bar[XB_TMO])) break; if (sp > XB_SPIN_CAP) { atomicAdd(&bar[XB_TMO], 1u); break; } }
    }
    nloc = mine > 0u ? mine : 1u; nx = cnt > 0u ? cnt : 1u;
}
__device__ __forceinline__ void xcd_barrier(const XcdBarrier& b) {
    asm volatile("s_waitcnt vmcnt(0)" ::: "memory");
    __syncthreads();
    if (tid_of(b.wv) == 0) {
        unsigned* bar = b.bar;
        __builtin_amdgcn_s_waitcnt(0);
        unsigned nloc = b.st[0], nx = b.st[1];
        if (nloc == 0u) { xcd_barrier_complete(bar, b.x, nloc, nx); b.st[0] = nloc; b.st[1] = nx; }
        const unsigned old = xb_add(&bar[XB_XSUB(b.x)], 1u);
        const unsigned gen = old / nloc;
        if (old + 1u == (gen + 1u) * nloc) {
            __builtin_amdgcn_fence(__ATOMIC_RELEASE, "agent");
            asm volatile("s_waitcnt vmcnt(0)" ::: "memory");
            const unsigned og = xb_add(&bar[XB_TOP], 1u);
            const unsigned tg = og / nx;
            if (og + 1u == (tg + 1u) * nx) xb_add(&bar[XB_TOPGEN], 1u);
            else XB_SPIN(xb_ld(&bar[XB_TOPGEN]) == tg, bar);
            __builtin_amdgcn_fence(__ATOMIC_ACQUIRE, "agent");
            xb_add(&bar[XB_XGEN(b.x)], 1u);
            asm volatile("s_waitcnt vmcnt(0)" ::: "memory");
        } else {
            XB_SPIN(xb_ld(&bar[XB_XGEN(b.x)]) == gen, bar);
            __builtin_amdgcn_fence(__ATOMIC_ACQUIRE, "agent");
            asm volatile("s_waitcnt vmcnt(0)" ::: "memory");
        }
    }
    __syncthreads();
}

typedef float f32x4t __attribute__((ext_vector_type(4)));
struct TItem { const float* W; bf16* WT; int K, N, k0, n0, dest_row0; };
__device__ __forceinline__ void titem_load(const TItem& t, f32x4t (&r)[8], int lane) {
    const float* p = t.W + (size_t)(t.k0 + (lane >> 3)) * t.N + t.n0 + 4 * (lane & 7);
#pragma unroll
    for (int i = 0; i < 8; ++i) r[i] = __builtin_nontemporal_load((const f32x4t*)(p + (size_t)(8 * i) * t.N));
}
__device__ __forceinline__ void titem_finish(const TItem& t, const f32x4t (&r)[8], LAS float* scr, int lane) {
    LAS float* w = scr + (lane >> 3) * 33 + 4 * (lane & 7);
#pragma unroll
    for (int i = 0; i < 8; ++i) { w[(8 * i) * 33 + 0] = r[i].x; w[(8 * i) * 33 + 1] = r[i].y; w[(8 * i) * 33 + 2] = r[i].z; w[(8 * i) * 33 + 3] = r[i].w; }
    LDS_WAIT(); asm volatile("" ::: "memory");
    const int c = lane & 7;
#pragma unroll
    for (int j = 0; j < 4; ++j) { const int n = (lane >> 3) + 8 * j; const LAS float* s = scr + (8 * c) * 33 + n;
        v4u o; o.x = pk2(s[0 * 33], s[1 * 33]); o.y = pk2(s[2 * 33], s[3 * 33]); o.z = pk2(s[4 * 33], s[5 * 33]); o.w = pk2(s[6 * 33], s[7 * 33]);
        __builtin_nontemporal_store(o, (v4u*)(t.WT + (size_t)(t.dest_row0 + n) * t.K + t.k0 + 8 * c)); }
    LDS_WAIT(); asm volatile("" ::: "memory");
}
struct Args { const float* in[15]; float* out; unsigned char* ws; int ph_lo, ph_hi; };
__device__ __forceinline__ void titem_decode(const __attribute__((address_space(4))) Args* ap, unsigned char* ws, int it, TItem& t) {
    constexpr int I_W1 = (DM / 64) * (2 * DFF / 32), I_W2 = (DFF / 64) * (DM / 32), I_AIN = (DM / 64) * (NQKVA / 32), I_SQ = (DM / 64) * (DM / 32), I_KV = (DM / 64) * (2 * DM / 32);
    constexpr int E0 = 8 * I_W1, E1 = E0 + 8 * I_W2, E2 = E1 + 2 * I_AIN, E3 = E2 + 2 * I_SQ, E4 = E3 + I_KV, E5 = E4 + 2 * I_SQ;
    int kb, nb;
    if (it < E0) {
        const int mi = it / I_W1, r = it % I_W1, nblk = 2 * DFF / 32; kb = r / nblk; nb = r % nblk; const int n0 = nb * 32, isup = n0 >= DFF, hid = n0 - isup * DFF;
        t.W = ap->in[2] + (size_t)mi * DM * 2 * DFF; t.K = DM; t.N = 2 * DFF; t.WT = (bf16*)(ws + WS_W1 + (size_t)mi * W1_SZ); t.dest_row0 = 256 * (hid >> 7) + 128 * isup + (hid & 127);
    } else if (it < E1) {
        const int q = it - E0, mi = q / I_W2, r = q % I_W2, nblk = DM / 32; kb = r / nblk; nb = r % nblk;
        t.W = ap->in[3] + (size_t)mi * DFF * DM; t.K = DFF; t.N = DM; t.WT = (bf16*)(ws + WS_W2 + (size_t)mi * W2_SZ); t.dest_row0 = nb * 32;
    } else if (it < E2) {
        const int q = it - E1, mi = q / I_AIN, r = q % I_AIN, nblk = NQKVA / 32; kb = r / nblk; nb = r % nblk;
        t.W = ap->in[5] + (size_t)mi * DM * NQKVA; t.K = DM; t.N = NQKVA; t.WT = (bf16*)(ws + WS_WAIN + (size_t)mi * WAIN_SZ); t.dest_row0 = nb * 32;
    } else if (it < E3) {
        const int q = it - E2, mi = q / I_SQ, r = q % I_SQ, nblk = DM / 32; kb = r / nblk; nb = r % nblk;
        t.W = ap->in[7] + (size_t)mi * DM * DM; t.K = DM; t.N = DM; t.WT = (bf16*)(ws + WS_WAOUT + (size_t)mi * WSQ_SZ); t.dest_row0 = nb * 32;
    } else if (it < E4) {
        const int r = it - E3, nblk = 2 * DM / 32; kb = r / nblk; nb = r % nblk;
        t.W = ap->in[9]; t.K = DM; t.N = 2 * DM; t.WT = (bf16*)(ws + WS_WKV); t.dest_row0 = nb * 32;
    } else if (it < E5) {
        const int q = it - E4, mi = q / I_SQ, r = q % I_SQ, nblk = DM / 32; kb = r / nblk; nb = r % nblk;
        t.W = ap->in[10] + (size_t)mi * DM * DM; t.K = DM; t.N = DM; t.WT = (bf16*)(ws + WS_WQB + (size_t)mi * WSQ_SZ); t.dest_row0 = nb * 32;
    } else {
        const int q = it - E5, mi = q / I_SQ, r = q % I_SQ, nblk = DM / 32; kb = r / nblk; nb = r % nblk;
        t.W = ap->in[13] + (size_t)mi * DM * DM; t.K = DM; t.N = DM; t.WT = (bf16*)(ws + WS_WOB + (size_t)mi * WSQ_SZ); t.dest_row0 = nb * 32;
    }
    t.k0 = 64 * kb; t.n0 = 32 * nb;
}
__device__ __forceinline__ void prologue_weights(const __attribute__((address_space(4))) Args* ap, LAS unsigned char* lds, int vcu, int G, int wv) {
    const int tid_ = tid_of(wv); const int lane = tid_ & 63, wave = __builtin_amdgcn_readfirstlane(tid_ >> 6), gw = vcu * NWAVES + wave, NGW = G * NWAVES; (void)wave; (void)gw; (void)NGW; (void)lane;
    LAS float* scr = (LAS float*)(lds + RING_OFF + wave * 16384);
    constexpr int I_W1 = (DM / 64) * (2 * DFF / 32), I_W2 = (DFF / 64) * (DM / 32), I_AIN = (DM / 64) * (NQKVA / 32), I_SQ = (DM / 64) * (DM / 32), I_KV = (DM / 64) * (2 * DM / 32);
    constexpr int E6 = 8 * I_W1 + 8 * I_W2 + 2 * I_AIN + 2 * I_SQ + I_KV + 2 * I_SQ + 2 * I_SQ;
    unsigned char* ws = ap->ws;
    int it = gw; if (it >= E6) return;
    TItem ta, tb; f32x4t ra[8], rb[8];
    titem_decode(ap, ws, it, ta); titem_load(ta, ra, lane);
    for (;;) {
        const int i1 = it + NGW; const bool h1 = i1 < E6; titem_decode(ap, ws, h1 ? i1 : it, tb); titem_load(tb, rb, lane);
        titem_finish(ta, ra, scr, lane);
        if (!h1) break;
        const int i2 = i1 + NGW; const bool h2 = i2 < E6; titem_decode(ap, ws, h2 ? i2 : i1, ta); titem_load(ta, ra, lane);
        titem_finish(tb, rb, scr, lane);
        if (!h2) break;
        it = i2;
    }
}
typedef _Float16 h16x8 __attribute__((ext_vector_type(8)));
template <bool OUT_F32, bool SRC16>
__device__ __forceinline__ void norm_phase(const void* src, const float* g, void* dst, LAS unsigned char* lds, int vcu, int G, int wv) {
    const int tid_ = tid_of(wv); const int lane = tid_ & 63, wave = __builtin_amdgcn_readfirstlane(tid_ >> 6), gw = vcu * NWAVES + wave, NGW = G * NWAVES;
#define NP_IDX(j) (SRC16 ? (2 * lane + 128 * ((j) >> 1) + ((j) & 1)) : (lane + 64 * (j)))
#define NP_LOAD(V, M) do { if (SRC16) { const h16x8* xr_ = (const h16x8*)((const _Float16*)src + (size_t)(M) * DM) + lane; _Pragma("unroll") for (int j = 0; j < 8; ++j) { const h16x8 c_ = xr_[64 * j]; \
            V[2 * j] = (f32x4){(float)c_[0], (float)c_[1], (float)c_[2], (float)c_[3]}; V[2 * j + 1] = (f32x4){(float)c_[4], (float)c_[5], (float)c_[6], (float)c_[7]}; } } \
        else { const f32x4* xr_ = (const f32x4*)((const float*)src + (size_t)(M) * DM); _Pragma("unroll") for (int j = 0; j < 16; ++j) V[j] = xr_[NP_IDX(j)]; } } while (0)
#define NP_PROC(V, M) do { float s_ = 0.f; _Pragma("unroll") for (int j = 0; j < 16; ++j) s_ += (V[j].x * V[j].x + V[j].y * V[j].y) + (V[j].z * V[j].z + V[j].w * V[j].w); \
        const float rstd_ = 1.0f / sqrtf(wave_sum(s_) * (1.f / DM) + EPS); \
        if (OUT_F32) { f32x4* o_ = (f32x4*)((float*)dst + (size_t)(M) * DM); _Pragma("unroll") for (int j = 0; j < 16; ++j) o_[NP_IDX(j)] = V[j] * rstd_ * gl[64 * j]; } \
        else { v2u* o_ = (v2u*)((bf16*)dst + (size_t)(M) * DM); _Pragma("unroll") for (int j = 0; j < 16; ++j) { const f32x4 y = V[j] * rstd_ * gl[64 * j]; v2u w; w.x = pk2(y.x, y.y); w.y = pk2(y.z, y.w); o_[NP_IDX(j)] = w; } } } while (0)
    { LAS f32x4* gs = (LAS f32x4*)(lds + RING_OFF);
#pragma unroll
      for (int r = 0; r < 2; ++r) { const int sl = tid_ + 512 * r, j = sl >> 6, l = sl & 63; gs[sl] = ((const f32x4*)g)[SRC16 ? (2 * l + 128 * (j >> 1) + (j & 1)) : (l + 64 * j)]; }
      __syncthreads(); }
    const LAS f32x4* gl = (const LAS f32x4*)(lds + RING_OFF) + lane;
    int m = gw; if (m >= SEQ) return;
    f32x4 va[16], vb[16];
    NP_LOAD(va, m);
    for (;;) {
        const int m1 = m + NGW; const bool h1 = m1 < SEQ; NP_LOAD(vb, (h1 ? m1 : m));
        NP_PROC(va, m);
        if (!h1) break;
        const int m2 = m1 + NGW; const bool h2 = m2 < SEQ; NP_LOAD(va, (h2 ? m2 : m1));
        NP_PROC(vb, m1);
        if (!h2) break;
        m = m2;
    }
#undef NP_LOAD
#undef NP_PROC
#undef NP_IDX
}
__device__ __forceinline__ void fgate_phase(const bf16* HN, const bf16* Wf, const float* bfv, float* LOGF, int vcu, int G, int wv) {
    const int tid_ = tid_of(wv); const int lane = tid_ & 63, wave = __builtin_amdgcn_readfirstlane(tid_ >> 6), gw = vcu * NWAVES + wave, NGW = G * NWAVES; (void)wave; (void)gw; (void)NGW; (void)lane;
    const int fr = lane & 15, fq = lane >> 4;
    for (int u = gw; u < SEQ / 16; u += NGW) {
        const int t0 = u * 16;
        f32x4 acc0 = {0.f, 0.f, 0.f, 0.f}, acc1 = {0.f, 0.f, 0.f, 0.f};
        const bf16* ap = HN + (size_t)(t0 + fr) * DM + fq * 8; const bf16* bp0 = Wf + (size_t)fr * DM + fq * 8; const bf16* bp1 = bp0 + (size_t)16 * DM;
#pragma unroll 8
        for (int k = 0; k < DM; k += 32) {
            const bf16x8 av = *(const bf16x8*)(ap + k), b0 = *(const bf16x8*)(bp0 + k), b1 = *(const bf16x8*)(bp1 + k);
            acc0 = __builtin_amdgcn_mfma_f32_16x16x32_bf16(av, b0, acc0, 0, 0, 0); acc1 = __builtin_amdgcn_mfma_f32_16x16x32_bf16(av, b1, acc1, 0, 0, 0);
        }
        const float c0 = bfv[fr], c1 = bfv[16 + fr]; f32x4 o0, o1;
#pragma unroll
        for (int j = 0; j < 4; ++j) { const float x0 = acc0[j] + c0, x1 = acc1[j] + c1;
            o0[j] = fminf(x0, 0.f) - log1pf(expf(-fabsf(x0))); o1[j] = fminf(x1, 0.f) - log1pf(expf(-fabsf(x1))); }
        *(f32x4*)(LOGF + (size_t)fr * SEQ + t0 + fq * 4) = o0; *(f32x4*)(LOGF + (size_t)(16 + fr) * SEQ + t0 + fq * 4) = o1;
    }
}
__device__ __forceinline__ void cumsum_phase(const float* LOGF, float* ND2, LAS unsigned char* lds, int vcu, int G, int wv) {
    const int tid_ = tid_of(wv); const int lane = tid_ & 63, wave = __builtin_amdgcn_readfirstlane(tid_ >> 6);
    static_assert(SEQ == NWAVES * 32 * 64, "cumsum_phase: 8 waves x 32 chunks x 64 lanes");
    volatile LAS float* tot = (volatile LAS float*)(lds + RING_OFF);
    for (int h = vcu; h < HA; h += G) {
        const float* src = LOGF + (size_t)h * SEQ + wave * 2048 + lane; float* dst = ND2 + (size_t)h * SEQ + wave * 2048 + lane;
        float x[32];
#pragma unroll
        for (int c = 0; c < 32; ++c) x[c] = src[c * 64];
        float carry = 0.f;
#pragma unroll
        for (int c = 0; c < 32; ++c) { const float v = wave_incl_scan(x[c]); x[c] = v + carry; carry += lanef(v, 63); }
        if (lane == 0) tot[wave] = carry;
        __syncthreads();
        float base = 0.f;
#pragma unroll
        for (int w = 0; w < NWAVES; ++w) { const float t = tot[w]; base += (w < wave) ? t : 0.f; }
#pragma unroll
        for (int c = 0; c < 32; ++c) dst[c * 64] = -LOG2E_F * (x[c] + base);
        __syncthreads();
    }
}
__device__ __forceinline__ void norms_phase(const bf16* Q, const bf16* K, float* QN, float* KN, float* DG, int vcu, int G, int wv) {
    const int tid_ = tid_of(wv); const int lane = tid_ & 63, wave = __builtin_amdgcn_readfirstlane(tid_ >> 6), gw = vcu * NWAVES + wave, NGW = G * NWAVES;
    for (int u = gw; u < 64 * 32; u += NGW) {
        const int qb = u >> 5, hm = u & 31; const size_t off = (size_t)(qb * 256 + (lane >> 4)) * DM + hm * 128 + (lane & 15) * 8;
        const bf16* pq = Q + off; const bf16* pk = K + off; float mq = 0.f, mk = 0.f, md = 3.0e38f;
#define TB_LOAD(WQ, WK, B) do { _Pragma("unroll") for (int i = 0; i < 8; ++i) { WQ[i] = *(const v4u*)(pq + (size_t)((B) * 8 + i) * 4 * DM); WK[i] = *(const v4u*)(pk + (size_t)((B) * 8 + i) * 4 * DM); } } while (0)
#define TB_PROC(WQ, WK) do { _Pragma("unroll") for (int i = 0; i < 8; ++i) { const v4u wq = WQ[i], wk = WK[i]; float sq = 0.f, sk = 0.f, sd = 0.f; \
            _Pragma("unroll") for (int q = 0; q < 4; ++q) { const unsigned uq = wq[q], uk = wk[q]; const float ql = __uint_as_float(uq << 16), qh = __uint_as_float(uq & 0xffff0000u), kl = __uint_as_float(uk << 16), kh = __uint_as_float(uk & 0xffff0000u); \
                sq = fmaf(ql, ql, sq); sq = fmaf(qh, qh, sq); sk = fmaf(kl, kl, sk); sk = fmaf(kh, kh, sk); sd = fmaf(ql, kl, sd); sd = fmaf(qh, kh, sd); } \
            sq = row16_sum(sq); sk = row16_sum(sk); sd = row16_sum(sd); mq = fmaxf(mq, sq); mk = fmaxf(mk, sk); md = fminf(md, sd); } } while (0)
        v4u qa[8], ka[8], qb2[8], kb2[8];
        TB_LOAD(qa, ka, 0);
#pragma unroll
        for (int b = 0; b < 8; b += 2) { TB_LOAD(qb2, kb2, b + 1); TB_PROC(qa, ka); if (b + 2 < 8) TB_LOAD(qa, ka, b + 2); TB_PROC(qb2, kb2); }
#undef TB_LOAD
#undef TB_PROC
        mq = fmaxf(fmaxf(lanef(mq, 0), lanef(mq, 16)), fmaxf(lanef(mq, 32), lanef(mq, 48))); mk = fmaxf(fmaxf(lanef(mk, 0), lanef(mk, 16)), fmaxf(lanef(mk, 32), lanef(mk, 48)));
        md = fminf(fminf(lanef(md, 0), lanef(md, 16)), fminf(lanef(md, 32), lanef(md, 48)));
        if (lane == 0) { QN[u] = mq; KN[u] = mk; DG[u] = md; }
    }
}
__device__ __forceinline__ void combine_phase(const _Float16* OV, const float* lamv, const float* gsub, float lam_init, bf16* ATT, int vcu, int G, int wv) {
    const int tid_ = tid_of(wv); const int lane = tid_ & 63, wave = __builtin_amdgcn_readfirstlane(tid_ >> 6), gw = vcu * NWAVES + wave, NGW = G * NWAVES;
    const float s1 = wave_sum(lamv[lane] * lamv[128 + lane] + lamv[64 + lane] * lamv[192 + lane]);
    const float s2 = wave_sum(lamv[256 + lane] * lamv[384 + lane] + lamv[320 + lane] * lamv[448 + lane]);
    const float lam = expf(s1) - expf(s2) + lam_init, post = 1.0f - lam_init;
    const f32x4 gv = ((const f32x4*)gsub)[lane];
    for (int it0 = gw; it0 < SEQ * HB; it0 += 8 * NGW) {
        typedef _Float16 h16x4 __attribute__((ext_vector_type(4)));
        h16x4 ha[8], hb[8];
#pragma unroll
        for (int k = 0; k < 8; ++k) { const int it_ = it0 + k * NGW, it = it_ < SEQ * HB ? it_ : it0, t = it >> 4, h = it & 15;
            ha[k] = ((const h16x4*)(OV + (size_t)t * 8192 + (size_t)(2 * h) * 256))[lane]; hb[k] = ((const h16x4*)(OV + (size_t)t * 8192 + (size_t)(2 * h + 1) * 256))[lane]; }
#pragma unroll
        for (int k = 0; k < 8; ++k) { const int it = it0 + k * NGW; if (it < SEQ * HB) { const int t = it >> 4, h = it & 15;
            const f32x4 a = {(float)ha[k][0], (float)ha[k][1], (float)ha[k][2], (float)ha[k][3]}, b = {(float)hb[k][0], (float)hb[k][1], (float)hb[k][2], (float)hb[k][3]};
            const f32x4 o = a - b * lam;
            const float rstd = 1.0f / sqrtf(wave_sum((o.x * o.x + o.y * o.y) + (o.z * o.z + o.w * o.w)) * (1.f / 256.f) + EPS);
            const f32x4 y = o * (rstd * post) * gv; v2u w; w.x = pk2(y.x, y.y); w.y = pk2(y.z, y.w);
            ((v2u*)(ATT + (size_t)t * DM + h * 256))[lane] = w; } }
    }
}

typedef const __attribute__((address_space(4))) Args* CArgs;
__device__ __forceinline__ CArgs KA() { CArgs p = (CArgs)__builtin_amdgcn_kernarg_segment_ptr(); asm volatile("" : "+s"(p)); return p; }
#define WSP(off) (KA()->ws + (off))
#define INP(i) (KA()->in[i])
__global__ void __launch_bounds__(NWAVES * 64, 2) fwd_kernel(Args args) {
    extern __shared__ __attribute__((aligned(16))) unsigned char lds[];
    LAS unsigned char* const L = (LAS unsigned char*)lds;
    volatile LAS unsigned* const MISC = (volatile LAS unsigned*)(L + MISC_OFF);
    const int tid = threadIdx.x, wv = __builtin_amdgcn_readfirstlane(tid >> 6);
    const int G = gridDim.x, bx = blockIdx.x;
    const int vcu = (G % 8 == 0) ? (bx % 8) * (G / 8) + bx / 8 : bx;
    for (int u = tid; u < (LDS_BYTES - LDSCTL_OFF) / 4; u += NWAVES * 64) ((LAS unsigned*)(L + LDSCTL_OFF))[u] = 0u;
    __syncthreads();
#if MK_MULTI_LAUNCH
#define GRID_BAR() do { if (tid == 0) __hip_atomic_store((unsigned*)WSP(WS_CTL) + CW_TMO, 0xBADBA0u, __ATOMIC_RELAXED, __HIP_MEMORY_SCOPE_AGENT); } while (0)
#else
    XcdBarrier bar = xcd_barrier_post((unsigned*)WSP(WS_CTL) + CW_BAR, MISC + 8, wv);
#define GRID_BAR() xcd_barrier(bar)
#endif
    const int lo = KA()->ph_lo, hi = KA()->ph_hi; int ph = 0;
#ifndef PHASE_MASK
#define PHASE_MASK 0xFFFFFFFFu
#endif
#define HASP(k) (((PHASE_MASK) >> (k)) & 1u)
#define RUN() (lo <= ph && ph < hi)
#define SEAM() do { if (RUN() && ph + 1 < hi) GRID_BAR(); ++ph; } while (0)
#define GEMM_SITE(EPI, Aoff, Boff, N_, K_, ...) do { pg8::Gemm g{(const bf16*)WSP(Aoff), (const bf16*)WSP(Boff), SEQ, (N_), (K_)}; pg8::StaticOrder S; S.init(SEQ, (N_), G, bx); \
        pg8::EPI E{__VA_ARGS__}; pg8::gemm_phase<pg8::EPI, pg8::StaticOrder, pg8::EPI::ALIGN, true>(L + RING_OFF, g, S, E, wv); } while (0)

    if (HASP(0) && RUN()) prologue_weights(KA(), L, vcu, G, wv);
    SEAM();
    for (int s = 0; s < 2 * DEPTH; ++s) {
        const int l = s >> 1, j = s & 1;
        if (HASP(1) && RUN()) { if (s == 0) norm_phase<false, false>(INP(0), INP(1), WSP(WS_HN), L, vcu, G, wv); else norm_phase<false, true>(WSP(WS_H), INP(1) + (size_t)(l * 2 + j) * DM, WSP(WS_HN), L, vcu, G, wv); }
        SEAM();
        if (HASP(2) && RUN()) GEMM_SITE(EpiSwiGLU, WS_HN, WS_W1 + (size_t)s * W1_SZ, 2 * DFF, DM, (bf16*)WSP(WS_ACT), DFF);
        SEAM();
        if (HASP(3) && RUN()) GEMM_SITE(EpiResidF16, WS_ACT, WS_W2 + (size_t)s * W2_SZ, DM, DFF, s == 0 ? INP(0) : (const float*)nullptr, (_Float16*)WSP(WS_H), DM, 0.5f);
        SEAM();
        if (j == 0) {
            if (HASP(1) && RUN()) norm_phase<false, true>(WSP(WS_H), INP(4) + (size_t)l * DM, WSP(WS_HN), L, vcu, G, wv);
            SEAM();
            if (l < NA) {
                if (HASP(4) && RUN()) { GEMM_SITE(EpiBf16, WS_HN, WS_WAIN + (size_t)l * WAIN_SZ, 3 * DM, DM, (bf16*)WSP(WS_Q), DM, DM, (size_t)SEQ * DM);
                    fgate_phase((const bf16*)WSP(WS_HN), (const bf16*)WSP(WS_WAIN + (size_t)l * WAIN_SZ) + (size_t)3 * DM * DM, INP(6) + l * HA, (float*)WSP(WS_LOGF), vcu, G, wv); }
                SEAM();
                if (HASP(5) && RUN()) { cumsum_phase((const float*)WSP(WS_LOGF), (float*)WSP(WS_ND2), L, vcu, G, wv); norms_phase((const bf16*)WSP(WS_Q), (const bf16*)WSP(WS_K), (float*)WSP(WS_QN), (float*)WSP(WS_KN), (float*)WSP(WS_DG), vcu, G, wv); }
                SEAM();
                if (HASP(6) && RUN()) { att::AttnCfg c{(const bf16*)WSP(WS_Q), (const bf16*)WSP(WS_K), (const bf16*)WSP(WS_V), (void*)WSP(WS_ATT), (const float*)WSP(WS_ND2), (const float*)WSP(WS_QN), (const float*)WSP(WS_KN), (const float*)WSP(WS_DG)};
                    att::attn_phase<0, att::bf16_t, 4096>((char*)lds + RING_OFF, c, G, bx, wv); }
                SEAM();
                if (HASP(7) && RUN()) GEMM_SITE(EpiResidF16, WS_ATT, WS_WAOUT + (size_t)l * WSQ_SZ, DM, DM, (const float*)nullptr, (_Float16*)WSP(WS_H), DM, 1.0f);
                SEAM();
            } else {
                const int jb = l - NA;
                if (HASP(8) && RUN()) GEMM_SITE(EpiBf16, WS_HN, WS_WQB + (size_t)jb * WSQ_SZ, DM, DM, (bf16*)WSP(WS_Q), DM, 0, 0);
                SEAM();
                if (HASP(5) && RUN()) norms_phase((const bf16*)WSP(WS_Q), (const bf16*)WSP(WS_KSH), (float*)WSP(WS_QN), (float*)WSP(WS_KN), (float*)WSP(WS_DG), vcu, G, wv);
                SEAM();
                if (HASP(9) && RUN()) { att::AttnCfg c{(const bf16*)WSP(WS_Q), (const bf16*)WSP(WS_KSH), (const bf16*)WSP(WS_VSH), (void*)WSP(WS_OV), nullptr, (const float*)WSP(WS_QN), (const float*)WSP(WS_KN), (const float*)WSP(WS_DG)};
                    att::attn_phase<1, _Float16, 8192>((char*)lds + RING_OFF, c, G, bx, wv); }
                SEAM();
                if (HASP(10) && RUN()) combine_phase((const _Float16*)WSP(WS_OV), INP(11) + (size_t)jb * 512, INP(12) + (size_t)jb * 256, 0.8f - 0.6f * expf(-0.3f * (float)l), (bf16*)WSP(WS_ATT), vcu, G, wv);
                SEAM();
                if (HASP(11) && RUN()) GEMM_SITE(EpiResidF16, WS_ATT, WS_WOB + (size_t)jb * WSQ_SZ, DM, DM, (const float*)nullptr, (_Float16*)WSP(WS_H), DM, 1.0f);
                SEAM();
            }
        } else if (l == NA - 1) {
            if (HASP(1) && RUN()) norm_phase<false, true>(WSP(WS_H), INP(8), WSP(WS_HN), L, vcu, G, wv);
            SEAM();
            if (HASP(12) && RUN()) GEMM_SITE(EpiBf16, WS_HN, WS_WKV, 2 * DM, DM, (bf16*)WSP(WS_KSH), DM, DM, (size_t)SEQ * DM);
            SEAM();
        }
    }
    if (HASP(13) && RUN()) norm_phase<true, true>(WSP(WS_H), INP(14), KA()->out, L, vcu, G, wv);
    ++ph;
#undef RUN
#undef HASP
#undef SEAM
#undef GRID_BAR
#undef GEMM_SITE
}
constexpr int N_PHASES = 1 + 8 * 3 + 2 * 5 + 2 * 6 + 2 + 1;

extern "C" void kernel_launch(void* const* d_in, const int* in_sizes, int n_in, void* d_out, int out_size, void* d_ws, size_t ws_size, hipStream_t stream) {
    static int grid = 0;
    if (grid == 0) {
        if (n_in != 15 || in_sizes[0] != SEQ * DM || out_size != SEQ * DM || ws_size < WS_END) { fprintf(stderr, "kernel_launch: shape/workspace mismatch (n_in %d, in0 %d, out %d, ws %zu, need %zu); nothing launched\n", n_in, n_in > 0 ? in_sizes[0] : -1, out_size, ws_size, (size_t)WS_END); grid = -1; return; }
        int dev = 0, cus = 0, per_cu = 0;
        if (hipGetDevice(&dev) != hipSuccess || hipDeviceGetAttribute(&cus, hipDeviceAttributeMultiprocessorCount, dev) != hipSuccess) { fprintf(stderr, "kernel_launch: device query failed\n"); grid = -1; return; }
        if (hipFuncSetAttribute((const void*)fwd_kernel, hipFuncAttributeMaxDynamicSharedMemorySize, LDS_BYTES) != hipSuccess) { fprintf(stderr, "kernel_launch: hipFuncSetAttribute failed\n"); grid = -1; return; }
        if (hipOccupancyMaxActiveBlocksPerMultiprocessor(&per_cu, (const void*)fwd_kernel, NWAVES * 64, LDS_BYTES) != hipSuccess || per_cu < 1) { fprintf(stderr, "kernel_launch: occupancy query reports %d workgroups per CU\n", per_cu); }
        (void)hipGetLastError();
        grid = cus;
    }
    if (grid < 0) return;
    if (hipMemsetAsync((char*)d_ws + WS_CTL, 0, CTL_ZERO_BYTES, stream) != hipSuccess) { fprintf(stderr, "kernel_launch: hipMemsetAsync failed\n"); return; }
    Args a{};
    for (int i = 0; i < 15; ++i) a.in[i] = (const float*)d_in[i];
    a.out = (float*)d_out; a.ws = (unsigned char*)d_ws;
#if MK_MULTI_LAUNCH
    for (int p = 0; p < N_PHASES; ++p) { a.ph_lo = p; a.ph_hi = p + 1; hipLaunchKernelGGL(fwd_kernel, dim3(grid), dim3(NWAVES * 64), LDS_BYTES, stream, a); }
#else
    a.ph_lo = 0; a.ph_hi = N_PHASES; hipLaunchKernelGGL(fwd_kernel, dim3(grid), dim3(NWAVES * 64), LDS_BYTES, stream, a);
#endif
#ifdef PROBE_EXTRA
    { static const int extra[] = PROBE_EXTRA; for (unsigned i = 0; i < sizeof(extra) / sizeof(extra[0]); ++i) { a.ph_lo = extra[i]; a.ph_hi = extra[i] + 1; hipLaunchKernelGGL(fwd_kernel, dim3(grid), dim3(NWAVES * 64), LDS_BYTES, stream, a); } }
#endif
    const hipError_t le = hipPeekAtLastError();
    if (le != hipSuccess) fprintf(stderr, "kernel_launch: launch failed: %s\n", hipGetErrorName(le));
}
```
